# Optimizing an MI355X kernel written in HIP

```python
import math
import jax, jax.numpy as jnp
from jax import lax
import numpy as np

D_MODEL = 1024
BATCH = 8
SEQ = 4096
DEPTH = 4

GRID_W = 64
CTX_LEN = 256
N_AB = (DEPTH + 1) // 2
N_C = DEPTH // 2
A_HEADS = 8
A_KV_HEADS = 2
A_HEAD_DIM = 64
A_WIDTH = A_HEADS * A_HEAD_DIM
A_KV_WIDTH = A_KV_HEADS * A_HEAD_DIM
WINDOW = 128
Q_BLOCK = WINDOW
ROPE_BASE = 10000.0
B_WIDTH = D_MODEL // 2
CONV_W = 3
AB_IN_WIDTH = 2 * A_WIDTH + 2 * A_KV_WIDTH + 4 * B_WIDTH
AB_OUT_WIDTH = A_WIDTH + B_WIDTH
C_HEADS = 8
C_KEY_DIM = 128
C_VAL_DIM = D_MODEL // C_HEADS
C_F_WIDTH = C_HEADS * C_KEY_DIM
C_I_WIDTH = C_HEADS * C_VAL_DIM
C_IN_WIDTH = 3 * C_F_WIDTH + 2 * C_I_WIDTH
CHUNK = 32
DEEPNORM_ALPHA = (2 * DEPTH) ** 0.25
DEEPNORM_BETA = (8 * DEPTH) ** -0.25
LN_EPS = 1e-5
RMS_EPS = 1e-6

kernel_name = "hybrid_swa_shortconv_hgrn2_dit_block"


def split_cols(p, widths):
    idx = [int(v) for v in np.cumsum(widths)[:-1]]
    return jnp.split(p, idx, axis=-1)


def layer_norm(x, g, b):
    xf = x.astype(jnp.float32)
    mu = xf.mean(-1, keepdims=True)
    var = jnp.square(xf - mu).mean(-1, keepdims=True)
    return ((xf - mu) * lax.rsqrt(var + LN_EPS) * g + b).astype(x.dtype)


def modulate(h, shift, scale):
    return h * (1 + scale) + shift


def rope_1d(x, pos):
    half = x.shape[-1] // 2
    freqs = ROPE_BASE ** (-jnp.arange(half, dtype=jnp.float32) / half)
    ang = pos.astype(jnp.float32)[:, None] * freqs[None, :]
    cos = jnp.cos(ang)[:, None, :].astype(x.dtype)
    sin = jnp.sin(ang)[:, None, :].astype(x.dtype)
    x1, x2 = x[..., :half], x[..., half:]
    return jnp.concatenate([x1 * cos - x2 * sin, x1 * sin + x2 * cos], axis=-1)


def axial_rope(x, row, col):
    half = x.shape[-1] // 2
    return jnp.concatenate([rope_1d(x[..., :half], row), rope_1d(x[..., half:], col)], axis=-1)


def heads(t, n_heads):
    return t.reshape(t.shape[0], t.shape[1], n_heads, A_HEAD_DIM)


def short_conv(u, w):
    pad = CONV_W // 2
    L = u.shape[1]
    up = jnp.pad(u, ((0, 0), (pad, pad), (0, 0)))
    y = up[:, 0:L] * w[0]
    for j in range(1, CONV_W):
        y = y + up[:, j:j + L] * w[j]
    return y


def window_attention(q, k, v, kc, vc, sink):
    B, L = q.shape[:2]
    n_blk = L // Q_BLOCK
    G = A_HEADS // A_KV_HEADS
    scale = A_HEAD_DIM ** -0.5
    lc = kc.shape[1]
    span = Q_BLOCK + 2 * WINDOW
    qb = q.reshape(B, n_blk, Q_BLOCK, A_KV_HEADS, G, A_HEAD_DIM).swapaxes(0, 1)
    kp = jnp.pad(k, ((0, 0), (WINDOW, WINDOW), (0, 0), (0, 0)))
    vp = jnp.pad(v, ((0, 0), (WINDOW, WINDOW), (0, 0), (0, 0)))
    rel = jnp.arange(span)[None, :] - WINDOW - jnp.arange(Q_BLOCK)[:, None]
    in_win = jnp.abs(rel) <= WINDOW
    sink_l = jnp.broadcast_to(sink.astype(jnp.float32).reshape(1, A_KV_HEADS, G, 1, 1),
                              (B, A_KV_HEADS, G, Q_BLOCK, 1))

    def one_block(args):
        n, q_n = args
        start = n * Q_BLOCK
        k_n = lax.dynamic_slice_in_dim(kp, start, span, axis=1)
        v_n = lax.dynamic_slice_in_dim(vp, start, span, axis=1)
        key_pos = start - WINDOW + jnp.arange(span)
        valid = in_win & ((key_pos >= 0) & (key_pos < L))[None, :]
        s_loc = jnp.einsum('bikgd,bjkd->bkgij', q_n, k_n).astype(jnp.float32) * scale
        s_loc = jnp.where(valid, s_loc, -jnp.inf)
        s_ctx = jnp.einsum('bikgd,bjkd->bkgij', q_n, kc).astype(jnp.float32) * scale
        p = jax.nn.softmax(jnp.concatenate([sink_l, s_ctx, s_loc], axis=-1), axis=-1).astype(v.dtype)
        return (jnp.einsum('bkgij,bjkd->bikgd', p[..., 1:1 + lc], vc)
                + jnp.einsum('bkgij,bjkd->bikgd', p[..., 1 + lc:], v_n))

    out = lax.map(one_block, (jnp.arange(n_blk), qb))
    return out.swapaxes(0, 1).reshape(B, L, A_WIDTH)


def context_attention(qc, kc, vc, sink):
    B, lc = qc.shape[:2]
    G = A_HEADS // A_KV_HEADS
    q = qc.reshape(B, lc, A_KV_HEADS, G, A_HEAD_DIM)
    s = jnp.einsum('bikgd,bjkd->bkgij', q, kc).astype(jnp.float32) * (A_HEAD_DIM ** -0.5)
    sink_l = jnp.broadcast_to(sink.astype(jnp.float32).reshape(1, A_KV_HEADS, G, 1, 1),
                              (B, A_KV_HEADS, G, lc, 1))
    p = jax.nn.softmax(jnp.concatenate([sink_l, s], axis=-1), axis=-1).astype(vc.dtype)
    return jnp.einsum('bkgij,bjkd->bikgd', p[..., 1:], vc).reshape(B, lc, A_WIDTH)


def ab_layer(x, xc, mod, mod_c, w_in, w_out, sink, conv_w, ln_g, ln_b, row, col, ctx_out):
    shift, scale, gate = jnp.split(mod, 3, axis=-1)
    shift_c, scale_c, gate_c = jnp.split(mod_c, 3, axis=-1)
    widths = (A_WIDTH, A_KV_WIDTH, A_KV_WIDTH, A_WIDTH, B_WIDTH, B_WIDTH, B_WIDTH, B_WIDTH)
    q, k, v, g_a, xb, b_g, c_g, g_b = split_cols(modulate(x, shift, scale) @ w_in, widths)
    hc = modulate(xc, shift_c, scale_c)
    if ctx_out:
        qc, kc, vc, g_ac, xbc, b_gc, c_gc, g_bc = split_cols(hc @ w_in, widths)
    else:
        kc, vc = split_cols(hc @ w_in[:, A_WIDTH:A_WIDTH + 2 * A_KV_WIDTH], (A_KV_WIDTH, A_KV_WIDTH))
    kc, vc = heads(kc, A_KV_HEADS), heads(vc, A_KV_HEADS)
    q = axial_rope(heads(q, A_HEADS), row, col)
    k = axial_rope(heads(k, A_KV_HEADS), row, col)
    o_a = window_attention(q, k, heads(v, A_KV_HEADS), kc, vc, sink)
    o_b = b_g * short_conv(c_g * xb, conv_w)
    y = jnp.concatenate([o_a * jax.nn.silu(g_a), o_b * jax.nn.silu(g_b)], axis=-1) @ w_out
    x_new = layer_norm(DEEPNORM_ALPHA * x + gate * y, ln_g, ln_b)
    if not ctx_out:
        return x_new, None
    o_ac = context_attention(heads(qc, A_HEADS), kc, vc, sink)
    o_bc = b_gc * short_conv(c_gc * xbc, conv_w)
    yc = jnp.concatenate([o_ac * jax.nn.silu(g_ac), o_bc * jax.nn.silu(g_bc)], axis=-1) @ w_out
    xc_new = layer_norm(DEEPNORM_ALPHA * xc + gate_c * yc, ln_g, ln_b)
    return x_new, xc_new


def to_heads(t, d):
    B, L, _ = t.shape
    return t.reshape(B, L, -1, d).transpose(0, 2, 1, 3).astype(jnp.float32)


def forget_terms(z, lb):
    lb = jnp.clip(lb.astype(jnp.float32), 0.0, 1.0).reshape(C_HEADS, 1, C_KEY_DIM)
    log_f = jnp.logaddexp(jnp.log(lb), jnp.log1p(-lb) + jax.nn.log_sigmoid(z))
    k = (1 - lb) * jax.nn.sigmoid(-z)
    return k, log_f


def hgrn2_scan(q, k, v, log_f, s0, with_outputs):
    B, H, L, dk = k.shape
    n = L // CHUNK
    chunks = lambda t: t.reshape(B, H, n, CHUNK, t.shape[-1])
    to_scan = lambda t: jnp.moveaxis(t, 2, 0)
    k, v, log_f = chunks(k), chunks(v), chunks(log_f)
    b = jnp.cumsum(log_f, axis=3)
    b_last = b[:, :, :, -1:, :]
    k_state = k * jnp.exp(b_last - b)
    decay = jnp.exp(b_last[:, :, :, 0, :])
    if with_outputs:
        q = chunks(q)
        q_inter = q * jnp.exp(b)
        tri = jnp.tril(jnp.ones((CHUNK, CHUNK), dtype=bool))[:, :, None]

        def step(s, xs):
            q_n, k_n, v_n, b_n, qi_n, ks_n, d_n = xs
            o_inter = jnp.einsum('bhcd,bhde->bhce', qi_n, s)
            diff = b_n[:, :, :, None, :] - b_n[:, :, None, :, :]
            w = jnp.exp(jnp.where(tri, diff, -jnp.inf))
            scores = jnp.einsum('bhcd,bhsd,bhcsd->bhcs', q_n, k_n, w)
            o_n = o_inter + jnp.einsum('bhcs,bhse->bhce', scores, v_n)
            return d_n[..., None] * s + jnp.einsum('bhcd,bhce->bhde', ks_n, v_n), o_n

        s_final, o = lax.scan(step, s0, (to_scan(q), to_scan(k), to_scan(v), to_scan(b),
                                         to_scan(q_inter), to_scan(k_state), to_scan(decay)))
        o = jnp.moveaxis(o, 0, 2).reshape(B, H, L, v.shape[-1])
        return o, s_final

    def step_state(s, xs):
        k_n, v_n, d_n = xs
        return d_n[..., None] * s + jnp.einsum('bhcd,bhce->bhde', k_n, v_n), None

    s_final, _ = lax.scan(step_state, s0, (to_scan(k_state), to_scan(v), to_scan(decay)))
    return None, s_final


def hgrn2_direction(q, i, z, lb, qc, ic, zc, ctx_out, reverse):
    flip = (lambda t: jnp.flip(t, axis=2)) if reverse else (lambda t: t)
    B = i.shape[0]
    kc, lfc = forget_terms(zc, lb)
    s0 = jnp.zeros((B, C_HEADS, C_KEY_DIM, C_VAL_DIM), jnp.float32)
    oc, s_ctx = hgrn2_scan(flip(qc) if ctx_out else None, flip(kc), flip(ic), flip(lfc), s0, ctx_out)
    k, lf = forget_terms(z, lb)
    o, _ = hgrn2_scan(flip(q), flip(k), flip(i), flip(lf), s_ctx, True)
    return flip(o), (flip(oc) if ctx_out else None)


def hgrn2_readout(o, g, g_norm, w_out):
    on = o * lax.rsqrt(jnp.mean(o * o, axis=-1, keepdims=True) + RMS_EPS) * g_norm
    B, H, L, dv = on.shape
    return (on.transpose(0, 2, 1, 3).reshape(B, L, H * dv).astype(g.dtype) * jax.nn.silu(g)) @ w_out


def c_layer(x, xc, mod, mod_c, w_in, w_out, lb_f, lb_b, g_norm, ln_g, ln_b, ctx_out):
    shift, scale, gate = jnp.split(mod, 3, axis=-1)
    shift_c, scale_c, gate_c = jnp.split(mod_c, 3, axis=-1)
    widths = (C_F_WIDTH, C_F_WIDTH, C_F_WIDTH, C_I_WIDTH, C_I_WIDTH)
    q, zf, zb, i, g = split_cols(modulate(x, shift, scale) @ w_in, widths)
    hc = modulate(xc, shift_c, scale_c)
    if ctx_out:
        qc, zfc, zbc, ic, gc = split_cols(hc @ w_in, widths)
        qc = jax.nn.silu(to_heads(qc, C_KEY_DIM)) * (C_KEY_DIM ** -0.5)
    else:
        zfc, zbc, ic = split_cols(hc @ w_in[:, C_F_WIDTH:3 * C_F_WIDTH + C_I_WIDTH],
                                  (C_F_WIDTH, C_F_WIDTH, C_I_WIDTH))
        qc = None
    q = jax.nn.silu(to_heads(q, C_KEY_DIM)) * (C_KEY_DIM ** -0.5)
    i, zf, zb = to_heads(i, C_VAL_DIM), to_heads(zf, C_KEY_DIM), to_heads(zb, C_KEY_DIM)
    ic, zfc, zbc = to_heads(ic, C_VAL_DIM), to_heads(zfc, C_KEY_DIM), to_heads(zbc, C_KEY_DIM)
    o_f, oc_f = hgrn2_direction(q, i, zf, lb_f, qc, ic, zfc, ctx_out, reverse=False)
    o_b, oc_b = hgrn2_direction(q, i, zb, lb_b, qc, ic, zbc, ctx_out, reverse=True)
    y = hgrn2_readout(o_f + o_b, g, g_norm, w_out)
    x_new = layer_norm(DEEPNORM_ALPHA * x + gate * y, ln_g, ln_b)
    if not ctx_out:
        return x_new, None
    yc = hgrn2_readout(oc_f + oc_b, gc, g_norm, w_out)
    xc_new = layer_norm(DEEPNORM_ALPHA * xc + gate_c * yc, ln_g, ln_b)
    return x_new, xc_new


def setup_inputs(seed: int = 0) -> dict:
    key = jax.random.key(seed)
    ks = jax.random.split(key, 16)
    nrm = lambda k, shape, s: jax.random.normal(k, shape, jnp.float32) * s
    ab_col_scale = jnp.concatenate([
        jnp.ones((A_WIDTH + A_KV_WIDTH,), jnp.float32),
        jnp.full((A_KV_WIDTH,), DEEPNORM_BETA, jnp.float32),
        jnp.ones((A_WIDTH + 4 * B_WIDTH,), jnp.float32)])
    c_col_scale = jnp.concatenate([
        jnp.ones((3 * C_F_WIDTH,), jnp.float32),
        jnp.full((C_I_WIDTH,), DEEPNORM_BETA, jnp.float32),
        jnp.ones((C_I_WIDTH,), jnp.float32)])
    return {
        "x": nrm(ks[0], (BATCH, SEQ, D_MODEL), 1.0),
        "c": nrm(ks[1], (BATCH, D_MODEL), 1.0),
        "ctx": nrm(ks[2], (BATCH, CTX_LEN, D_MODEL), 1.0),
        "c_ctx": nrm(ks[3], (D_MODEL,), 1.0),
        "w_ada": nrm(ks[4], (DEPTH, D_MODEL, 3 * D_MODEL), D_MODEL ** -0.5),
        "b_ada": nrm(ks[5], (DEPTH, 3 * D_MODEL), 0.02),
        "ln_g": 1.0 + nrm(ks[6], (DEPTH, D_MODEL), 0.02),
        "ln_b": nrm(ks[7], (DEPTH, D_MODEL), 0.02),
        "w_in_ab": nrm(ks[8], (N_AB, D_MODEL, AB_IN_WIDTH), D_MODEL ** -0.5) * ab_col_scale,
        "w_out_ab": nrm(ks[9], (N_AB, AB_OUT_WIDTH, D_MODEL), AB_OUT_WIDTH ** -0.5 * DEEPNORM_BETA),
        "sink_ab": nrm(ks[10], (N_AB, A_HEADS), 0.5),
        "conv_ab": nrm(ks[11], (N_AB, CONV_W, B_WIDTH), CONV_W ** -0.5),
        "w_in_c": nrm(ks[12], (N_C, D_MODEL, C_IN_WIDTH), D_MODEL ** -0.5) * c_col_scale,
        "w_out_c": nrm(ks[13], (N_C, C_I_WIDTH, D_MODEL), C_I_WIDTH ** -0.5 * DEEPNORM_BETA),
        "lb_c": nrm(ks[14], (2, N_C, C_F_WIDTH), 0.5),
        "gnorm_c": 1.0 + nrm(ks[15], (N_C, C_VAL_DIM), 0.02),
    }


def reference(x, c, ctx, c_ctx, w_ada, b_ada, ln_g, ln_b, w_in_ab, w_out_ab, sink_ab, conv_ab,
              w_in_c, w_out_c, lb_c, gnorm_c):
    L = x.shape[1]
    rows = L // GRID_W
    row = jnp.repeat(jnp.arange(rows), GRID_W)
    col = jnp.tile(jnp.arange(GRID_W), rows)
    lb_p = jax.nn.softmax(lb_c.astype(jnp.float32), axis=1)
    lb_all = jnp.cumsum(lb_p, axis=1) - lb_p[:, :1]
    silu_c = jax.nn.silu(c)
    silu_cc = jax.nn.silu(c_ctx)
    xc = ctx
    for l in range(DEPTH):
        mod = (silu_c @ w_ada[l] + b_ada[l])[:, None, :]
        mod_c = silu_cc @ w_ada[l] + b_ada[l]
        ctx_out = l < DEPTH - 1
        j = l // 2
        if l % 2 == 0:
            x, xc = ab_layer(x, xc, mod, mod_c, w_in_ab[j], w_out_ab[j], sink_ab[j], conv_ab[j],
                             ln_g[l], ln_b[l], row, col, ctx_out)
        else:
            x, xc = c_layer(x, xc, mod, mod_c, w_in_c[j], w_out_c[j], lb_all[0, j], lb_all[1, j],
                            gnorm_c[j], ln_g[l], ln_b[l], ctx_out)
    return x
```

```cpp
#include <hip/hip_runtime.h>
#include <hip/hip_cooperative_groups.h>
#include <cstdio>
#include <cstdint>
namespace cg = cooperative_groups;
namespace pg8 {
#define PG8_LAS __attribute__((address_space(3)))
typedef unsigned short bf16_t;
typedef short bf16x8 __attribute__((ext_vector_type(8)));
typedef float f32x4 __attribute__((ext_vector_type(4)));
typedef unsigned u32x4 __attribute__((ext_vector_type(4)));
constexpr int BM = 256, BK = 64, HALF = 128, HTB = HALF * BK * 2  , STAGE_BYTES = 8 * HTB, NXCD = 8, WGM = 8;

__host__ __device__ __forceinline__ int lds_byte(int r, int c) { const int st = (r >> 4) * 2 + (c >> 5), rr = r & 15, cc = c & 31, ob = rr * 64 + cc * 2; return st * 1024 + (ob ^ (((ob >> 9) & 1) << 5)); }
__host__ __device__ __forceinline__ void stage_rc(int b, int& R, int& C) { const int st = b / 1024, sb = b % 1024, swz = sb ^ (((sb >> 9) & 1) << 5); R = (st >> 1) * 16 + swz / 64; C = (st & 1) * 32 + (swz % 64) / 2; }
__host__ __device__ __forceinline__ int perm32(int rho) { const int n = rho >> 4, i = rho & 15; return 8 * (i >> 2) + 4 * n + (i & 3); }

struct Unit { int pm, pn; };
struct Gemm { const bf16_t* A; const bf16_t* Bt; int M, N, K; };

struct StaticOrder {
    int nM, nN, nwg, G, c;
    __host__ __device__ void init(int M, int N, int G_, int c_) { nM = M / BM; nN = N / BM; nwg = nM * nN; G = G_; c = c_; }
    __host__ __device__ bool next(int i, Unit& u) const {
        const long L = (long)i * G + c; if (L >= nwg) return false;
        int wgid = (int)L; { const int q = nwg / NXCD, r = nwg % NXCD, xcd = wgid % NXCD, off = wgid / NXCD; wgid = (xcd < r ? xcd * (q + 1) : r * (q + 1) + (xcd - r) * q) + off; }
        const int nig = WGM * nN, gid = wgid / nig, fm = gid * WGM, gsz = (nM - fm) < WGM ? (nM - fm) : WGM;
        u.pm = fm + ((wgid % nig) % gsz); u.pn = (wgid % nig) / gsz; return true;
    }
    __device__ __forceinline__ void a_ready(const Unit&) const {}
    __device__ __forceinline__ void done(const Unit&) const {}
};

template <class Epi, class Sched, bool ALIGN_EPI = false, bool SP2 = false>
__device__ __forceinline__ void gemm_phase(PG8_LAS unsigned char* lds, const Gemm g, const Sched& S, const Epi& E) {
    const int tid = threadIdx.x, wid = __builtin_amdgcn_readfirstlane(tid >> 6), lane = tid & 63, wr = wid >> 2, wc = wid & 3, fr = lane & 15, fq = lane >> 4;
    const int K = g.K, nt = K / BK;
    unsigned voffA[2], voffB[2];
#pragma unroll
    for (int i = 0; i < 2; ++i) { int R, C; stage_rc(tid * 16 + i * 8192, R, C); const int Rb = Epi::PERM ? ((R & ~31) + perm32(R & 31)) : R;
        voffA[i] = (unsigned)(R * K + C) * 2u; voffB[i] = (unsigned)(Rb * K + C) * 2u; }
    const size_t kstep = (size_t)(BK * 2);
    const size_t hstep = (size_t)HALF * K * 2;
    const size_t tstep = 2 * hstep;
    const unsigned ldsw = (unsigned)wid * 1024u;
    const int aoff = lds_byte(wr * 64 + fr, fq * 8), boff = lds_byte(wc * 32 + fr, fq * 8);
#define PG8_SA(b, h) (((b) * 2 + (h)) * HTB)
#define PG8_SB(b, h) ((4 + (b) * 2 + (h)) * HTB)
#define PG8_STAGE(bufoff, gbase, voff) do { _Pragma("unroll") for (int _i = 0; _i < 2; ++_i) \
        __builtin_amdgcn_global_load_lds((const unsigned*)((const char*)(gbase) + (voff)[_i]), (PG8_LAS unsigned*)(lds + (bufoff) + ldsw + _i * 8192), 16, 0, 0); } while (0)
#define PG8_LDA(dst, b, h) do { _Pragma("unroll") for (int m = 0; m < 4; ++m) _Pragma("unroll") for (int k = 0; k < 2; ++k) dst[m][k] = *(const PG8_LAS bf16x8*)(lds + PG8_SA(b, h) + aoff + m * 2048 + k * 1024); } while (0)
#define PG8_LDB(dst, b, h) do { _Pragma("unroll") for (int n = 0; n < 2; ++n) _Pragma("unroll") for (int k = 0; k < 2; ++k) dst[n][k] = *(const PG8_LAS bf16x8*)(lds + PG8_SB(b, h) + boff + n * 2048 + k * 1024); } while (0)
#define PG8_MMA(ai, bj, At, Bt) do { __builtin_amdgcn_s_setprio(1); _Pragma("unroll") for (int m = 0; m < 4; ++m) _Pragma("unroll") for (int n = 0; n < 2; ++n) _Pragma("unroll") for (int k = 0; k < 2; ++k) \
        acc[ai][bj][m][n] = __builtin_amdgcn_mfma_f32_16x16x32_bf16(Bt[n][k], At[m][k], acc[ai][bj][m][n], 0, 0, 0); __builtin_amdgcn_s_setprio(0); } while (0)
#define PG8_WAIT_V(n) asm volatile("s_waitcnt vmcnt(" #n ")" ::: "memory")
#define PG8_WAIT_L(n) asm volatile("s_waitcnt lgkmcnt(" #n ")" ::: "memory")
#define PG8_BAR __builtin_amdgcn_s_barrier()
#define PG8_SCHED __builtin_amdgcn_sched_barrier(0)
    Unit cur, nxt; int ui = 0;
    if (!S.next(0, cur)) return;
    f32x4 acc[2][2][4][2];
#pragma unroll
    for (int a = 0; a < 2; ++a)
#pragma unroll
        for (int b = 0; b < 2; ++b)
#pragma unroll
            for (int m = 0; m < 4; ++m)
#pragma unroll
                for (int n = 0; n < 2; ++n) acc[a][b][m][n] = (f32x4){0.f, 0.f, 0.f, 0.f};
    bf16x8 At[4][2], B0[2][2], B1[2][2];
    const char* cA = (const char*)g.A + (size_t)cur.pm * tstep; const char* cB = (const char*)g.Bt + (size_t)cur.pn * tstep;
    S.a_ready(cur);
    if constexpr (SP2) {
        PG8_STAGE(PG8_SB(0, 0), cB, voffB); PG8_STAGE(PG8_SB(0, 1), cB + hstep, voffB); PG8_STAGE(PG8_SA(0, 0), cA, voffA); PG8_STAGE(PG8_SA(0, 1), cA + hstep, voffA);
        if (wr == 1) PG8_BAR;
        PG8_WAIT_V(2); PG8_BAR;
        PG8_STAGE(PG8_SB(1, 0), cB + kstep, voffB); PG8_STAGE(PG8_SA(1, 0), cA + kstep, voffA); PG8_STAGE(PG8_SB(1, 1), cB + hstep + kstep, voffB);
        PG8_WAIT_V(6); PG8_BAR;
    } else {
        PG8_STAGE(PG8_SB(0, 0), cB, voffB); PG8_STAGE(PG8_SA(0, 0), cA, voffA); PG8_STAGE(PG8_SB(0, 1), cB + hstep, voffB); PG8_STAGE(PG8_SA(0, 1), cA + hstep, voffA);
        if (wr == 1) PG8_BAR;
        PG8_WAIT_V(4); PG8_BAR;
        PG8_STAGE(PG8_SB(1, 0), cB + kstep, voffB); PG8_STAGE(PG8_SA(1, 0), cA + kstep, voffA); PG8_STAGE(PG8_SB(1, 1), cB + hstep + kstep, voffB);
        PG8_WAIT_V(6); PG8_BAR;
    }
    for (;;) {
        const bool has_next = S.next(ui + 1, nxt);
        const char* nA = has_next ? (const char*)g.A + (size_t)nxt.pm * tstep : cA; const char* nB = has_next ? (const char*)g.Bt + (size_t)nxt.pn * tstep : cB;
        for (int t = 0; t < nt; t += 2) {
            const bool last = (t == nt - 2);
            const char* a1 = cA + (size_t)(t + 1) * kstep;
            const char* a2 = last ? nA : cA + (size_t)(t + 2) * kstep; const char* b2 = last ? nB : cB + (size_t)(t + 2) * kstep;
            const char* a3 = a2 + kstep; const char* b3 = b2 + kstep;
            if (last && has_next) S.a_ready(nxt);
            if constexpr (SP2) {
            PG8_LDB(B0, 0, 0); PG8_LDB(B1, 0, 1); PG8_SCHED; PG8_LDA(At, 0, 0); PG8_STAGE(PG8_SA(1, 1), a1 + hstep, voffA);
            PG8_WAIT_V(8); PG8_WAIT_L(0); PG8_BAR; PG8_MMA(0, 0, At, B0); PG8_MMA(0, 1, At, B1); PG8_BAR; PG8_SCHED;
            PG8_LDA(At, 0, 1); PG8_STAGE(PG8_SB(0, 0), b2, voffB); PG8_STAGE(PG8_SB(0, 1), b2 + hstep, voffB); PG8_STAGE(PG8_SA(0, 0), a2, voffA);
            PG8_WAIT_V(8); PG8_WAIT_L(0); PG8_BAR; PG8_MMA(1, 0, At, B0); PG8_MMA(1, 1, At, B1); PG8_BAR; PG8_SCHED;
            PG8_LDB(B0, 1, 0); PG8_LDB(B1, 1, 1); PG8_SCHED; PG8_LDA(At, 1, 0); PG8_STAGE(PG8_SA(0, 1), a2 + hstep, voffA);
            PG8_WAIT_V(8); PG8_WAIT_L(0); PG8_BAR; PG8_MMA(0, 0, At, B0); PG8_MMA(0, 1, At, B1); PG8_BAR; PG8_SCHED;
            PG8_LDA(At, 1, 1); PG8_STAGE(PG8_SB(1, 0), b3, voffB); PG8_STAGE(PG8_SB(1, 1), b3 + hstep, voffB); PG8_STAGE(PG8_SA(1, 0), a3, voffA);
            PG8_WAIT_V(8); PG8_WAIT_L(0); PG8_BAR; PG8_MMA(1, 0, At, B0); PG8_MMA(1, 1, At, B1); PG8_BAR; PG8_SCHED;
            } else {
            PG8_LDB(B0, 0, 0); PG8_SCHED; PG8_LDA(At, 0, 0); PG8_STAGE(PG8_SA(1, 1), a1 + hstep, voffA);
            PG8_WAIT_L(8); PG8_BAR; PG8_WAIT_L(0); PG8_MMA(0, 0, At, B0); PG8_BAR; PG8_SCHED;
            PG8_LDB(B1, 0, 1); PG8_STAGE(PG8_SB(0, 0), b2, voffB);
            PG8_BAR; PG8_WAIT_L(0); PG8_MMA(0, 1, At, B1); PG8_BAR;
            PG8_LDA(At, 0, 1); PG8_STAGE(PG8_SA(0, 0), a2, voffA);
            PG8_BAR; PG8_WAIT_L(0); PG8_MMA(1, 0, At, B0); PG8_BAR; PG8_SCHED;
            PG8_STAGE(PG8_SB(0, 1), b2 + hstep, voffB);
            PG8_WAIT_V(6); PG8_BAR; PG8_MMA(1, 1, At, B1); PG8_BAR;
            PG8_LDB(B0, 1, 0); PG8_SCHED; PG8_LDA(At, 1, 0); PG8_STAGE(PG8_SA(0, 1), a2 + hstep, voffA);
            PG8_WAIT_L(8); PG8_BAR; PG8_WAIT_L(0); PG8_MMA(0, 0, At, B0); PG8_BAR; PG8_SCHED;
            PG8_LDB(B1, 1, 1); PG8_STAGE(PG8_SB(1, 0), b3, voffB);
            PG8_BAR; PG8_WAIT_L(0); PG8_MMA(0, 1, At, B1); PG8_BAR;
            PG8_LDA(At, 1, 1); PG8_STAGE(PG8_SA(1, 0), a3, voffA);
            PG8_BAR; PG8_WAIT_L(0); PG8_MMA(1, 0, At, B0); PG8_BAR; PG8_SCHED;
            PG8_STAGE(PG8_SB(1, 1), b3 + hstep, voffB);
            PG8_WAIT_V(6); PG8_BAR; PG8_MMA(1, 1, At, B1); PG8_BAR;
            }
        }
        if constexpr (ALIGN_EPI) { if (wr == 0) PG8_BAR; }
        if constexpr (!Epi::AFTER_DRAIN) { E(acc, cur, wr, wc, fr, fq); S.done(cur); }
        if (!has_next) break;
#pragma unroll
        for (int a = 0; a < 2; ++a)
#pragma unroll
            for (int b = 0; b < 2; ++b)
#pragma unroll
                for (int m = 0; m < 4; ++m)
#pragma unroll
                    for (int n = 0; n < 2; ++n) acc[a][b][m][n] = (f32x4){0.f, 0.f, 0.f, 0.f};
        cur = nxt; cA = nA; cB = nB; ++ui;
        if constexpr (ALIGN_EPI) { if (wr == 1) PG8_BAR; }
    }
    PG8_WAIT_V(0);
    if constexpr (!ALIGN_EPI) { if (wr == 0) PG8_BAR; }
    PG8_BAR;
    if constexpr (Epi::AFTER_DRAIN) { E.fused(acc, cur, wr, wc, fr, fq, lds, wid, lane); S.done(cur); }
#undef PG8_SA
#undef PG8_SB
#undef PG8_STAGE
#undef PG8_LDA
#undef PG8_LDB
#undef PG8_MMA
#undef PG8_WAIT_V
#undef PG8_WAIT_L
#undef PG8_BAR
#undef PG8_SCHED
}
}

#ifndef PG8_SP2
#define PG8_SP2 true
#endif
#ifndef PG8_ALIGN
#define PG8_ALIGN true
#endif

constexpr int DM = 1024, NB = 8, SEQ = 4096, CTXL = 256, DEPTH = 4;
constexpr int MLAT = NB * SEQ, MCTX = NB * CTXL, MTOT = MLAT + MCTX;
constexpr int NAB = 3328, NCC = 5120;
constexpr float LN_EPS = 1e-5f, RMS_EPS = 1e-6f;
constexpr float DN_ALPHA = 1.681792830507429f;
constexpr float QSCALE = 0.125f * 1.4426950408889634f;
constexpr float LOG2E = 1.4426950408889634f;
constexpr int NWAVES = 8, NTHR = 512;

constexpr size_t MiB = 1u << 20;
constexpr size_t WS_WINAB = 1 * MiB, WS_WOUTAB = 14 * MiB, WS_WINC = 18 * MiB, WS_WOUTC = 38 * MiB;
constexpr size_t WS_MOD = 42 * MiB, WS_LB = 42 * MiB + 512 * 1024, WS_ROPE = 42 * MiB + 640 * 1024;
constexpr size_t WS_XC = 44 * MiB;
constexpr size_t WS_HU = 52 * MiB;
constexpr size_t WS_PROJ = 120 * MiB;
constexpr size_t WS_END = 460 * MiB;
constexpr int LDS_BYTES = 147456;

#define LAS __attribute__((address_space(3)))
typedef unsigned short bf16_t;
typedef short bf16x8 __attribute__((ext_vector_type(8)));
typedef float f32x4 __attribute__((ext_vector_type(4)));
typedef float f32x16 __attribute__((ext_vector_type(16)));
typedef unsigned u32x4 __attribute__((ext_vector_type(4)));
typedef unsigned u32x2 __attribute__((ext_vector_type(2)));
typedef float f32x2_t __attribute__((ext_vector_type(2)));
typedef __bf16 bf16x2_t __attribute__((ext_vector_type(2)));
typedef _Float16 f16x2_t __attribute__((ext_vector_type(2)));

__device__ __forceinline__ unsigned pkbf(float lo, float hi) { f32x2_t v = {lo, hi}; bf16x2_t b = __builtin_convertvector(v, bf16x2_t); return __builtin_bit_cast(unsigned, b); }
__device__ __forceinline__ unsigned pkh(float lo, float hi) { f32x2_t v = {lo, hi}; f16x2_t b = __builtin_convertvector(v, f16x2_t); return __builtin_bit_cast(unsigned, b); }
__device__ __forceinline__ unsigned short f2bf1(float f) { return (unsigned short)(pkbf(f, 0.f) & 0xffffu); }
__device__ __forceinline__ float bf2f(unsigned short u) { return __uint_as_float((unsigned)u << 16); }
__device__ __forceinline__ float bflo(unsigned u) { return __uint_as_float(u << 16); }
__device__ __forceinline__ float bfhi(unsigned u) { return __uint_as_float(u & 0xffff0000u); }
__device__ __forceinline__ float h2f(unsigned short u) { return (float)__builtin_bit_cast(_Float16, u); }
__device__ __forceinline__ float silu_f(float x) { return x / (1.f + __expf(-x)); }
__device__ __forceinline__ float wave_sum(float v) {
#pragma unroll
    for (int o = 1; o < 64; o <<= 1) v += __shfl_xor(v, o);
    return v;
}

struct EpiAB {
    static constexpr bool PERM = false, AFTER_DRAIN = false;
    bf16_t* P; const float* rope;
    __device__ __forceinline__ void operator()(const pg8::f32x4 (&acc)[2][2][4][2], const pg8::Unit& u, int wr, int wc, int fr, int fq) const {
        const int row0 = u.pm * 256 + wr * 64 + fr;
        const int col0 = u.pn * 256 + wc * 32 + 4 * fq;
        const bool latent = u.pm < (MLAT / 256);
        const bool any_rope = latent && (u.pn <= 2);
#pragma unroll
        for (int ai = 0; ai < 2; ++ai)
#pragma unroll
            for (int m = 0; m < 4; ++m) {
                const int row = row0 + ai * 128 + m * 16;
                f32x4 cs0 = {1.f, 0.f, 1.f, 0.f}, cs1 = {1.f, 0.f, 1.f, 0.f};
                if (any_rope) {
                    const int t = row & (SEQ - 1); const int pos = (wc & 1) ? (t & 63) : (t >> 6);
                    const float* rp = rope + (pos * 16 + 4 * fq) * 2;
                    cs0 = *(const f32x4*)rp; cs1 = *(const f32x4*)(rp + 4);
                }
                bf16_t* rowp = P + (size_t)row * NAB + col0;
#pragma unroll
                for (int bj = 0; bj < 2; ++bj) {
                    const int colbase = u.pn * 256 + bj * 128;
                    f32x4 a = acc[ai][bj][m][0], b = acc[ai][bj][m][1];
                    if (latent && colbase < 640) {
                        f32x4 o1, o2;
                        o1[0] = a[0] * cs0[0] - b[0] * cs0[1]; o2[0] = a[0] * cs0[1] + b[0] * cs0[0];
                        o1[1] = a[1] * cs0[2] - b[1] * cs0[3]; o2[1] = a[1] * cs0[3] + b[1] * cs0[2];
                        o1[2] = a[2] * cs1[0] - b[2] * cs1[1]; o2[2] = a[2] * cs1[1] + b[2] * cs1[0];
                        o1[3] = a[3] * cs1[2] - b[3] * cs1[3]; o2[3] = a[3] * cs1[3] + b[3] * cs1[2];
                        a = o1; b = o2;
                    }
                    if (colbase < 512) { a = a * QSCALE; b = b * QSCALE; }
                    u32x2 w0, w1; w0.x = pkbf(a[0], a[1]); w0.y = pkbf(a[2], a[3]); w1.x = pkbf(b[0], b[1]); w1.y = pkbf(b[2], b[3]);
                    *(u32x2*)(rowp + bj * 128) = w0; *(u32x2*)(rowp + bj * 128 + 16) = w1;
                }
            }
    }
};
struct EpiC {
    static constexpr bool PERM = false, AFTER_DRAIN = false;
    bf16_t* P;
    __device__ __forceinline__ void operator()(const pg8::f32x4 (&acc)[2][2][4][2], const pg8::Unit& u, int wr, int wc, int fr, int fq) const {
        const int row0 = u.pm * 256 + wr * 64 + fr;
        const int col0 = u.pn * 256 + wc * 32 + 4 * fq;
        const int type = u.pn >> 2;
#pragma unroll
        for (int ai = 0; ai < 2; ++ai)
#pragma unroll
            for (int m = 0; m < 4; ++m) {
                bf16_t* rowp = P + (size_t)(row0 + ai * 128 + m * 16) * NCC + col0;
#pragma unroll
                for (int bj = 0; bj < 2; ++bj)
#pragma unroll
                    for (int n = 0; n < 2; ++n) {
                        f32x4 v = acc[ai][bj][m][n]; u32x2 w;
                        if (type == 0) {
#pragma unroll
                            for (int j = 0; j < 4; ++j) v[j] = silu_f(v[j]) * 0.08838834764831845f;
                            w.x = pkbf(v[0], v[1]); w.y = pkbf(v[2], v[3]);
                        } else if (type == 1 || type == 2) { w.x = pkh(v[0], v[1]); w.y = pkh(v[2], v[3]); }
                        else { w.x = pkbf(v[0], v[1]); w.y = pkbf(v[2], v[3]); }
                        *(u32x2*)(rowp + bj * 128 + n * 16) = w;
                    }
            }
    }
};
struct EpiOut {
    static constexpr bool PERM = false, AFTER_DRAIN = false;
    const float* xlat; const float* xctx; const float* gate; float* V;
    __device__ __forceinline__ void operator()(const pg8::f32x4 (&acc)[2][2][4][2], const pg8::Unit& u, int wr, int wc, int fr, int fq) const {
        const int row0 = u.pm * 256 + wr * 64 + fr;
        const int col0 = u.pn * 256 + wc * 32 + 4 * fq;
        const bool latent = u.pm < (MLAT / 256);
        const int mr = latent ? (u.pm >> 4) : 8;
        f32x4 g4[2][2];
#pragma unroll
        for (int bj = 0; bj < 2; ++bj)
#pragma unroll
            for (int n = 0; n < 2; ++n) g4[bj][n] = *(const f32x4*)(gate + (size_t)mr * 3072 + col0 + bj * 128 + n * 16);
#pragma unroll
        for (int ai = 0; ai < 2; ++ai)
#pragma unroll
            for (int m = 0; m < 4; ++m) {
                const int row = row0 + ai * 128 + m * 16;
                const float* xr = (latent ? xlat + (size_t)row * DM : xctx + (size_t)(row - MLAT) * DM) + col0;
                float* vr = V + (size_t)row * DM + col0;
#pragma unroll
                for (int bj = 0; bj < 2; ++bj)
#pragma unroll
                    for (int n = 0; n < 2; ++n) {
                        const f32x4 x4 = *(const f32x4*)(xr + bj * 128 + n * 16);
                        *(f32x4*)(vr + bj * 128 + n * 16) = x4 * DN_ALPHA + g4[bj][n] * acc[ai][bj][m][n];
                    }
            }
    }
};

__device__ __forceinline__ unsigned f2bf_bits(float f) { unsigned u = __builtin_bit_cast(unsigned, f); return (u + 0x7fffu + ((u >> 16) & 1u)) >> 16; }
__device__ __forceinline__ unsigned pk2(float lo, float hi) { return f2bf_bits(lo) | (f2bf_bits(hi) << 16); }
__device__ __forceinline__ void transpose_item(const float* W, int K, int N, bf16_t* WT, LAS float* scr, int item, int lane) {
    const int nblk = N / 32, kb = item / nblk, nb = item % nblk, k0 = 64 * kb, n0 = 32 * nb;
#pragma unroll 8
    for (int i = 0; i < 32; ++i) { const int kk = 2 * i + (lane >> 5); scr[kk * 33 + (lane & 31)] = W[(size_t)(k0 + kk) * N + n0 + (lane & 31)]; }
    asm volatile("s_waitcnt lgkmcnt(0)" ::: "memory");
    const int c = lane & 7;
#pragma unroll
    for (int j = 0; j < 4; ++j) { const int n = (lane >> 3) + 8 * j; const LAS float* s = scr + (8 * c) * 33 + n;
        u32x4 o; o.x = pk2(s[0 * 33], s[1 * 33]); o.y = pk2(s[2 * 33], s[3 * 33]); o.z = pk2(s[4 * 33], s[5 * 33]); o.w = pk2(s[6 * 33], s[7 * 33]);
        *(u32x4*)(WT + (size_t)(n0 + n) * K + k0 + 8 * c) = o; }
    asm volatile("s_waitcnt lgkmcnt(0)" ::: "memory");
}

struct Args {
    const float* x; const float* c; const float* ctx; const float* c_ctx; const float* w_ada; const float* b_ada; const float* ln_g; const float* ln_b;
    const float* w_in_ab; const float* w_out_ab; const float* sink_ab; const float* conv_ab; const float* w_in_c; const float* w_out_c; const float* lb_c; const float* gnorm_c;
    float* out; unsigned char* ws;
};

__device__ __forceinline__ void prologue_a(const Args& a, LAS unsigned char* lds, int tid, int bid, int G) {
    const int lane = tid & 63, wid = tid >> 6;
    float* mod = (float*)(a.ws + WS_MOD);
    for (int item = bid; item < 192; item += G) {
        const int l = item / 48, cgp = item % 48, col = cgp * 64 + lane;
        LAS float* s = (LAS float*)lds;
        for (int i = tid; i < 9 * 1024; i += NTHR) { const int r = i >> 10, k = i & 1023; const float cv = r < 8 ? a.c[r * 1024 + k] : a.c_ctx[k]; s[i] = silu_f(cv); }
        __syncthreads();
        const float* W = a.w_ada + (size_t)l * 1024 * 3072 + col;
        float acc[9];
#pragma unroll
        for (int r = 0; r < 9; ++r) acc[r] = 0.f;
        const int kbeg = wid * 128;
#pragma unroll 2
        for (int k = kbeg; k < kbeg + 128; k += 4) {
            const float w0 = W[(size_t)k * 3072], w1 = W[(size_t)(k + 1) * 3072], w2 = W[(size_t)(k + 2) * 3072], w3 = W[(size_t)(k + 3) * 3072];
#pragma unroll
            for (int r = 0; r < 9; ++r) { const f32x4 sv = *(const LAS f32x4*)(s + r * 1024 + k); acc[r] += sv[0] * w0 + sv[1] * w1 + sv[2] * w2 + sv[3] * w3; }
        }
        LAS float* red = (LAS float*)(lds + 40960);
#pragma unroll
        for (int r = 0; r < 9; ++r) red[(wid * 9 + r) * 64 + lane] = acc[r];
        __syncthreads();
        for (int t = tid; t < 576; t += NTHR) {
            const int r = t >> 6, cc = t & 63; float sum = 0.f;
#pragma unroll
            for (int w = 0; w < 8; ++w) sum += red[(w * 9 + r) * 64 + cc];
            mod[((size_t)l * 9 + r) * 3072 + cgp * 64 + cc] = sum + a.b_ada[l * 3072 + cgp * 64 + cc];
        }
        __syncthreads();
    }
    if (bid == G - 1) {
        float* lbv = (float*)(a.ws + WS_LB);
        for (int i = tid; i < 2048; i += NTHR) { const int d = i >> 10, cch = i & 1023; const float l0 = a.lb_c[(d * 2 + 0) * 1024 + cch], l1 = a.lb_c[(d * 2 + 1) * 1024 + cch];
            lbv[(d * 2 + 0) * 1024 + cch] = 0.f; lbv[(d * 2 + 1) * 1024 + cch] = 1.f / (1.f + __expf(l0 - l1)); }
    }
    if (bid == G - 2 || G == 1) {
        float* rp = (float*)(a.ws + WS_ROPE);
        for (int i = tid; i < 1024; i += NTHR) { const int pos = i >> 4, fi = i & 15; const float fr = exp2f(-(float)fi * (13.287712379549449f / 16.f)); const float ang = (float)pos * fr;
            rp[2 * i] = __cosf(ang); rp[2 * i + 1] = __sinf(ang); }
    }
    LAS float* scr = (LAS float*)(lds + wid * 16384);
    const int gw = bid * NWAVES + wid, NGW = G * NWAVES;
    constexpr int I_AB = 16 * (NAB / 32), I_O = 16 * 32, I_C = 16 * (NCC / 32);
    constexpr int NITEMS = 2 * (I_AB + I_O + I_C + I_O);
    for (int it = gw; it < NITEMS; it += NGW) {
        int r = it;
        if (r < 2 * I_AB) { const int j = r / I_AB; transpose_item(a.w_in_ab + (size_t)j * DM * NAB, DM, NAB, (bf16_t*)(a.ws + WS_WINAB) + (size_t)j * NAB * DM, scr, r % I_AB, lane); continue; } r -= 2 * I_AB;
        if (r < 2 * I_O) { const int j = r / I_O; transpose_item(a.w_out_ab + (size_t)j * DM * DM, DM, DM, (bf16_t*)(a.ws + WS_WOUTAB) + (size_t)j * DM * DM, scr, r % I_O, lane); continue; } r -= 2 * I_O;
        if (r < 2 * I_C) { const int j = r / I_C; transpose_item(a.w_in_c + (size_t)j * DM * NCC, DM, NCC, (bf16_t*)(a.ws + WS_WINC) + (size_t)j * NCC * DM, scr, r % I_C, lane); continue; } r -= 2 * I_C;
        { const int j = r / I_O; transpose_item(a.w_out_c + (size_t)j * DM * DM, DM, DM, (bf16_t*)(a.ws + WS_WOUTC) + (size_t)j * DM * DM, scr, r % I_O, lane); }
    }
}
__device__ __forceinline__ void prologue_b(const Args& a, int tid, int bid, int G) {
    const int lane = tid & 63, wid = tid >> 6;
    const float* mod = (const float*)(a.ws + WS_MOD);
    bf16_t* H = (bf16_t*)(a.ws + WS_HU);
    for (int m = bid * NWAVES + wid; m < MTOT; m += G * NWAVES) {
        const float* src = m < MLAT ? a.x + (size_t)m * DM : a.ctx + (size_t)(m - MLAT) * DM;
        const float* md = mod + (size_t)(m < MLAT ? (m >> 12) : 8) * 3072;
#pragma unroll
        for (int j = 0; j < 4; ++j) {
            const int cix = 4 * lane + 256 * j;
            const f32x4 v = *(const f32x4*)(src + cix), sh = *(const f32x4*)(md + cix), sc = *(const f32x4*)(md + 1024 + cix);
            const f32x4 o = v * (sc + 1.f) + sh;
            u32x2 w; w.x = pkbf(o[0], o[1]); w.y = pkbf(o[2], o[3]);
            *(u32x2*)(H + (size_t)m * DM + cix) = w;
        }
    }
}
__device__ __forceinline__ void ln_phase(const Args& a, int l, int mrows, int tid, int bid, int G) {
    const int lane = tid & 63, wid = tid >> 6;
    const float* V = (const float*)(a.ws + WS_PROJ);
    const float* mod = (const float*)(a.ws + WS_MOD) + (size_t)(l + 1) * 9 * 3072;
    float* XC = (float*)(a.ws + WS_XC);
    bf16_t* H = (bf16_t*)(a.ws + WS_HU);
    const float* gam = a.ln_g + l * DM; const float* bet = a.ln_b + l * DM;
    for (int m = bid * NWAVES + wid; m < mrows; m += G * NWAVES) {
        const float* vr = V + (size_t)m * DM;
        f32x4 v[4]; float s = 0.f;
#pragma unroll
        for (int j = 0; j < 4; ++j) { v[j] = *(const f32x4*)(vr + 4 * lane + 256 * j); s += (v[j][0] + v[j][1]) + (v[j][2] + v[j][3]); }
        const float mean = wave_sum(s) * (1.f / DM); float s2 = 0.f;
#pragma unroll
        for (int j = 0; j < 4; ++j) { v[j] = v[j] - mean; s2 += (v[j][0] * v[j][0] + v[j][1] * v[j][1]) + (v[j][2] * v[j][2] + v[j][3] * v[j][3]); }
        const float rstd = 1.f / sqrtf(wave_sum(s2) * (1.f / DM) + LN_EPS);
        float* xo = m < MLAT ? a.out + (size_t)m * DM : XC + (size_t)(m - MLAT) * DM;
        const float* md = mod + (size_t)(m < MLAT ? (m >> 12) : 8) * 3072;
#pragma unroll
        for (int j = 0; j < 4; ++j) {
            const int cix = 4 * lane + 256 * j;
            const f32x4 o = v[j] * rstd * *(const f32x4*)(gam + cix) + *(const f32x4*)(bet + cix);
            *(f32x4*)(xo + cix) = o;
            if (l < DEPTH - 1) {
                const f32x4 sh = *(const f32x4*)(md + cix), sc = *(const f32x4*)(md + 1024 + cix);
                const f32x4 hh = o * (sc + 1.f) + sh;
                u32x2 w; w.x = pkbf(hh[0], hh[1]); w.y = pkbf(hh[2], hh[3]);
                *(u32x2*)(H + (size_t)m * DM + cix) = w;
            }
        }
    }
}

__device__ __forceinline__ int crow(int r, int hi) { return (r & 3) + 8 * (r >> 2) + 4 * hi; }
constexpr int AT_KP = 72, AT_VP = 72, AT_OP = 68;
constexpr int AT_KS = 0, AT_VT = 2 * 64 * AT_KP * 2, AT_OS = AT_VT + 2 * 64 * AT_VP * 2;
__device__ __forceinline__ void attn_phase(LAS unsigned char* lds, const bf16_t* __restrict__ P, const float* __restrict__ sink, bf16_t* __restrict__ U, int tid, int bid, int G) {
    const int lane = tid & 63, wid = tid >> 6, q32 = lane & 31, hi = lane >> 5;
    LAS bf16_t* Ks = (LAS bf16_t*)(lds + AT_KS);
    LAS bf16_t* Vt = (LAS bf16_t*)(lds + AT_VT);
    LAS float* Os = (LAS float*)(lds + AT_OS) + wid * 32 * AT_OP;
    const int lkey = tid >> 3, lch = tid & 7;
    for (int u = bid; u < 1088; u += G) {
        bool isctx; int b, kh, qb;
        if (u < 64) { isctx = true; b = u >> 3; kh = (u >> 2) & 1; qb = u & 3; }
        else { const int v = u - 64; isctx = false; b = v >> 7; kh = (v >> 6) & 1; qb = v & 63; }
        const int h = kh * 4 + (wid & 3), rg = wid >> 2;
        const int qrow0 = (isctx ? MLAT + b * CTXL : b * SEQ) + qb * 64 + rg * 32;
        const int qpos = qb * 64 + rg * 32 + q32;
        bf16x8 qf[4];
#pragma unroll
        for (int kk = 0; kk < 4; ++kk) qf[kk] = *(const bf16x8*)(P + (size_t)(qrow0 + q32) * NAB + h * 64 + kk * 16 + hi * 8);
        int jlo = 0, nt = 4;
        if (!isctx) { jlo = qb < 2 ? 2 - qb : 0; const int jhi = (65 - qb) < 4 ? (65 - qb) : 4; nt = 4 + (jhi - jlo + 1); }
        float mrun = sink[h] * LOG2E, lrun = hi == 0 ? 1.f : 0.f;
        f32x16 o0, o1;
#pragma unroll
        for (int r = 0; r < 16; ++r) { o0[r] = 0.f; o1[r] = 0.f; }
        u32x4 kreg, vreg;
#define AT_LOAD(i) do { const int rb_ = (i) < 4 ? MLAT + b * CTXL + 64 * (i) : b * SEQ + 64 * (qb - 2 + jlo + (i) - 4); \
            const bf16_t* src_ = P + (size_t)(rb_ + lkey) * NAB + 512 + kh * 64 + lch * 8; kreg = *(const u32x4*)src_; vreg = *(const u32x4*)(src_ + 128); } while (0)
#define AT_STORE(buf) do { *(LAS u32x4*)(Ks + ((buf) * 64 + lkey) * AT_KP + lch * 8) = kreg; \
            LAS bf16_t* vd_ = Vt + ((buf) * 64 + lch * 8) * AT_VP + lkey; \
            vd_[0 * AT_VP] = (bf16_t)(vreg.x & 0xffffu); vd_[1 * AT_VP] = (bf16_t)(vreg.x >> 16); vd_[2 * AT_VP] = (bf16_t)(vreg.y & 0xffffu); vd_[3 * AT_VP] = (bf16_t)(vreg.y >> 16); \
            vd_[4 * AT_VP] = (bf16_t)(vreg.z & 0xffffu); vd_[5 * AT_VP] = (bf16_t)(vreg.z >> 16); vd_[6 * AT_VP] = (bf16_t)(vreg.w & 0xffffu); vd_[7 * AT_VP] = (bf16_t)(vreg.w >> 16); } while (0)
        AT_LOAD(0); AT_STORE(0);
        __syncthreads();
        for (int i = 0; i < nt; ++i) {
            const int buf = i & 1;
            if (i + 1 < nt) AT_LOAD(i + 1);
            f32x16 s0, s1;
#pragma unroll
            for (int r = 0; r < 16; ++r) { s0[r] = 0.f; s1[r] = 0.f; }
#pragma unroll
            for (int kk = 0; kk < 4; ++kk) {
                const bf16x8 a0 = *(const LAS bf16x8*)(Ks + (buf * 64 + q32) * AT_KP + kk * 16 + hi * 8);
                const bf16x8 a1 = *(const LAS bf16x8*)(Ks + (buf * 64 + 32 + q32) * AT_KP + kk * 16 + hi * 8);
                s0 = __builtin_amdgcn_mfma_f32_32x32x16_bf16(a0, qf[kk], s0, 0, 0, 0);
                s1 = __builtin_amdgcn_mfma_f32_32x32x16_bf16(a1, qf[kk], s1, 0, 0, 0);
            }
            if (i >= 4) {
                const int kp0 = 64 * (qb - 2 + jlo + i - 4) - qpos;
#pragma unroll
                for (int r = 0; r < 16; ++r) { const int d0 = kp0 + crow(r, hi); if (d0 > 128 || d0 < -128) s0[r] = -__builtin_inff(); const int d1 = d0 + 32; if (d1 > 128 || d1 < -128) s1[r] = -__builtin_inff(); }
            }
            float mx = s0[0];
#pragma unroll
            for (int r = 1; r < 16; ++r) mx = fmaxf(mx, s0[r]);
#pragma unroll
            for (int r = 0; r < 16; ++r) mx = fmaxf(mx, s1[r]);
            mx = fmaxf(mx, __shfl_xor(mx, 32));
            const float mnew = fmaxf(mrun, mx), alpha = __builtin_amdgcn_exp2f(mrun - mnew);
            mrun = mnew;
            float ls = 0.f;
#pragma unroll
            for (int r = 0; r < 16; ++r) { s0[r] = __builtin_amdgcn_exp2f(s0[r] - mnew); s1[r] = __builtin_amdgcn_exp2f(s1[r] - mnew); ls += s0[r] + s1[r]; }
            lrun = lrun * alpha + ls;
#pragma unroll
            for (int r = 0; r < 16; ++r) { o0[r] *= alpha; o1[r] *= alpha; }
#pragma unroll
            for (int sub = 0; sub < 2; ++sub)
#pragma unroll
                for (int st = 0; st < 2; ++st) {
                    u32x4 pw;
                    if (sub == 0) { pw.x = pkbf(s0[8 * st + 0], s0[8 * st + 1]); pw.y = pkbf(s0[8 * st + 2], s0[8 * st + 3]); pw.z = pkbf(s0[8 * st + 4], s0[8 * st + 5]); pw.w = pkbf(s0[8 * st + 6], s0[8 * st + 7]); }
                    else          { pw.x = pkbf(s1[8 * st + 0], s1[8 * st + 1]); pw.y = pkbf(s1[8 * st + 2], s1[8 * st + 3]); pw.z = pkbf(s1[8 * st + 4], s1[8 * st + 5]); pw.w = pkbf(s1[8 * st + 6], s1[8 * st + 7]); }
                    const bf16x8 pb = __builtin_bit_cast(bf16x8, pw);
                    const int kc = 32 * sub + 16 * st + 4 * hi;
                    {
                        const LAS bf16_t* vp = Vt + (buf * 64 + q32) * AT_VP + kc;
                        u32x4 aw; const u32x2 lo = *(const LAS u32x2*)vp, hh = *(const LAS u32x2*)(vp + 8); aw.x = lo.x; aw.y = lo.y; aw.z = hh.x; aw.w = hh.y;
                        o0 = __builtin_amdgcn_mfma_f32_32x32x16_bf16(__builtin_bit_cast(bf16x8, aw), pb, o0, 0, 0, 0);
                    }
                    {
                        const LAS bf16_t* vp = Vt + (buf * 64 + 32 + q32) * AT_VP + kc;
                        u32x4 aw; const u32x2 lo = *(const LAS u32x2*)vp, hh = *(const LAS u32x2*)(vp + 8); aw.x = lo.x; aw.y = lo.y; aw.z = hh.x; aw.w = hh.y;
                        o1 = __builtin_amdgcn_mfma_f32_32x32x16_bf16(__builtin_bit_cast(bf16x8, aw), pb, o1, 0, 0, 0);
                    }
                }
            if (i + 1 < nt) AT_STORE(buf ^ 1);
            __syncthreads();
        }
#undef AT_LOAD
#undef AT_STORE
        const float linv = 1.f / (lrun + __shfl_xor(lrun, 32));
#pragma unroll
        for (int r = 0; r < 16; ++r) { Os[q32 * AT_OP + crow(r, hi)] = o0[r] * linv; Os[q32 * AT_OP + 32 + crow(r, hi)] = o1[r] * linv; }
        asm volatile("s_waitcnt lgkmcnt(0)" ::: "memory");
#pragma unroll
        for (int it = 0; it < 4; ++it) {
            const int qq = it * 8 + (lane >> 3), ch = lane & 7;
            const f32x4 x0 = *(const LAS f32x4*)(Os + qq * AT_OP + ch * 8), x1 = *(const LAS f32x4*)(Os + qq * AT_OP + ch * 8 + 4);
            const size_t row = (size_t)(qrow0 + qq);
            const u32x4 gw = *(const u32x4*)(P + row * NAB + 768 + h * 64 + ch * 8);
            u32x4 w;
            w.x = pkbf(x0[0] * silu_f(bflo(gw.x)), x0[1] * silu_f(bfhi(gw.x))); w.y = pkbf(x0[2] * silu_f(bflo(gw.y)), x0[3] * silu_f(bfhi(gw.y)));
            w.z = pkbf(x1[0] * silu_f(bflo(gw.z)), x1[1] * silu_f(bfhi(gw.z))); w.w = pkbf(x1[2] * silu_f(bflo(gw.w)), x1[3] * silu_f(bfhi(gw.w)));
            *(u32x4*)(U + row * DM + h * 64 + ch * 8) = w;
        }
        asm volatile("s_waitcnt lgkmcnt(0)" ::: "memory");
    }
}
__device__ __forceinline__ void conv_phase(const bf16_t* __restrict__ P, const float* __restrict__ cw, bf16_t* __restrict__ U, int tid, int bid, int G) {
    const long total = (long)MTOT * 64;
    for (long idx = (long)bid * NTHR + tid; idx < total; idx += (long)G * NTHR) {
        const int ch = (int)(idx & 63); const int m = (int)(idx >> 6);
        int t, L; if (m < MLAT) { t = m & (SEQ - 1); L = SEQ; } else { t = (m - MLAT) & (CTXL - 1); L = CTXL; }
        const bf16_t* pr = P + (size_t)m * NAB + ch * 8;
        const u32x4 xb1 = *(const u32x4*)(pr + 1280), cg1 = *(const u32x4*)(pr + 2304), bg = *(const u32x4*)(pr + 1792), gb = *(const u32x4*)(pr + 2816);
        u32x4 xb0 = {0u, 0u, 0u, 0u}, cg0 = {0u, 0u, 0u, 0u}, xb2 = {0u, 0u, 0u, 0u}, cg2 = {0u, 0u, 0u, 0u};
        if (t > 0) { xb0 = *(const u32x4*)(pr - NAB + 1280); cg0 = *(const u32x4*)(pr - NAB + 2304); }
        if (t < L - 1) { xb2 = *(const u32x4*)(pr + NAB + 1280); cg2 = *(const u32x4*)(pr + NAB + 2304); }
        const float* w0 = cw + ch * 8; const float* w1 = cw + 512 + ch * 8; const float* w2 = cw + 1024 + ch * 8;
        const f32x4 w0a = *(const f32x4*)w0, w0b = *(const f32x4*)(w0 + 4), w1a = *(const f32x4*)w1, w1b = *(const f32x4*)(w1 + 4), w2a = *(const f32x4*)w2, w2b = *(const f32x4*)(w2 + 4);
        float o[8];
#define CV(j, XB0, CG0, XB1, CG1, XB2, CG2, BG, GB, W0, W1, W2, LOHI) { const float y = W0 * (LOHI(XB0) * LOHI(CG0)) + W1 * (LOHI(XB1) * LOHI(CG1)) + W2 * (LOHI(XB2) * LOHI(CG2)); o[j] = LOHI(BG) * y * silu_f(LOHI(GB)); }
        CV(0, xb0.x, cg0.x, xb1.x, cg1.x, xb2.x, cg2.x, bg.x, gb.x, w0a[0], w1a[0], w2a[0], bflo)
        CV(1, xb0.x, cg0.x, xb1.x, cg1.x, xb2.x, cg2.x, bg.x, gb.x, w0a[1], w1a[1], w2a[1], bfhi)
        CV(2, xb0.y, cg0.y, xb1.y, cg1.y, xb2.y, cg2.y, bg.y, gb.y, w0a[2], w1a[2], w2a[2], bflo)
        CV(3, xb0.y, cg0.y, xb1.y, cg1.y, xb2.y, cg2.y, bg.y, gb.y, w0a[3], w1a[3], w2a[3], bfhi)
        CV(4, xb0.z, cg0.z, xb1.z, cg1.z, xb2.z, cg2.z, bg.z, gb.z, w0b[0], w1b[0], w2b[0], bflo)
        CV(5, xb0.z, cg0.z, xb1.z, cg1.z, xb2.z, cg2.z, bg.z, gb.z, w0b[1], w1b[1], w2b[1], bfhi)
        CV(6, xb0.w, cg0.w, xb1.w, cg1.w, xb2.w, cg2.w, bg.w, gb.w, w0b[2], w1b[2], w2b[2], bflo)
        CV(7, xb0.w, cg0.w, xb1.w, cg1.w, xb2.w, cg2.w, bg.w, gb.w, w0b[3], w1b[3], w2b[3], bfhi)
#undef CV
        u32x4 w; w.x = pkbf(o[0], o[1]); w.y = pkbf(o[2], o[3]); w.z = pkbf(o[4], o[5]); w.w = pkbf(o[6], o[7]);
        *(u32x4*)(U + (size_t)m * DM + 512 + ch * 8) = w;
    }
}
constexpr int SC_QP = 136, SC_TP = 40;
constexpr int SC_QI = 0, SC_QA = SC_QI + 32 * SC_QP * 2, SC_KA = SC_QA + 32 * SC_QP * 2, SC_KST = SC_KA + 32 * SC_QP * 2, SC_VT = SC_KST + 128 * SC_TP * 2,
              SC_PM = SC_VT + 128 * SC_TP * 2, SC_DEC = SC_PM + 32 * SC_TP * 2, SC_BUF = SC_DEC + 512;
__device__ __forceinline__ void scan_phase(LAS unsigned char* lds, bf16_t* P, const float* __restrict__ lbv, int tid, int bid, int G) {
    const int lane = tid & 63, w = tid >> 6, d16 = lane & 15, quad = lane >> 4;
    for (int item = bid; item < 128; item += G) {
        const int dir = item & 1, bh = item >> 1, b = bh >> 3, h = bh & 7;
        const int d = 16 * w + d16;
        const float lb = lbv[dir * 2048 + h * 128 + d], omlb = 1.f - lb;
        const int zcol = (dir ? 2048 : 1024) + h * 128, qcol = h * 128, icol = 3072 + h * 128;
        f32x4 S[8];
#pragma unroll
        for (int i = 0; i < 8; ++i) S[i] = (f32x4){0.f, 0.f, 0.f, 0.f};
        unsigned short zr[8], qr[8]; u32x4 vreg;
        const int vp = tid >> 4, vch = tid & 15;
#define SC_ROWBASE(n) ((n) < 8 ? MLAT + b * CTXL + (dir ? 224 - 32 * (n) : 32 * (n)) : b * SEQ + (dir ? 4064 - 32 * ((n) - 8) : 32 * ((n) - 8)))
#define SC_LOAD(n) do { const int rb_ = SC_ROWBASE(n); \
            _Pragma("unroll") for (int i = 0; i < 8; ++i) { const int c_ = 8 * quad + i; const bf16_t* rp_ = P + (size_t)(rb_ + (dir ? 31 - c_ : c_)) * NCC; zr[i] = rp_[zcol + d]; qr[i] = rp_[qcol + d]; } \
            vreg = *(const u32x4*)(P + (size_t)(rb_ + vp) * NCC + icol + vch * 8); } while (0)
        SC_LOAD(0);
        for (int n = 0; n < 136; ++n) {
            LAS unsigned char* B = lds + (n & 1) * SC_BUF;
            LAS bf16_t* QI = (LAS bf16_t*)(B + SC_QI); LAS bf16_t* QA = (LAS bf16_t*)(B + SC_QA); LAS bf16_t* KA = (LAS bf16_t*)(B + SC_KA);
            LAS bf16_t* KST = (LAS bf16_t*)(B + SC_KST); LAS bf16_t* VT = (LAS bf16_t*)(B + SC_VT); LAS bf16_t* PM = (LAS bf16_t*)(B + SC_PM); LAS float* DEC = (LAS float*)(B + SC_DEC);
            const int rb = SC_ROWBASE(n);
            {
                float lf[8], kk[8];
#pragma unroll
                for (int i = 0; i < 8; ++i) {
                    const float z = h2f(zr[i]); const float e = __expf(-fabsf(z)); const float r1 = 1.f / (1.f + e);
                    const float sg = z >= 0.f ? r1 : e * r1, sgm = z >= 0.f ? e * r1 : r1;
                    lf[i] = __logf(lb + omlb * sg); kk[i] = omlb * sgm;
                }
                float cs[8]; float run = 0.f;
#pragma unroll
                for (int i = 0; i < 8; ++i) { run += lf[i]; cs[i] = run; }
                const float t0 = __shfl(run, d16), t1 = __shfl(run, d16 + 16), t2 = __shfl(run, d16 + 32), t3 = __shfl(run, d16 + 48);
                const float off = (quad > 0 ? t0 : 0.f) + (quad > 1 ? t1 : 0.f) + (quad > 2 ? t2 : 0.f);
                const float blast = (t0 + t1) + (t2 + t3), bref = t0 + t1;
                unsigned ksw[4];
#pragma unroll
                for (int i = 0; i < 8; i += 2) {
                    float ksv[2];
#pragma unroll
                    for (int jj = 0; jj < 2; ++jj) {
                        const int ii = i + jj; const float bi = cs[ii] + off; const float qv = bf2f(qr[ii]); const int c = 8 * quad + ii;
                        QI[c * SC_QP + d] = f2bf1(qv * __expf(bi)); QA[c * SC_QP + d] = f2bf1(qv * __expf(bi - bref)); KA[c * SC_QP + d] = f2bf1(kk[ii] * __expf(bref - bi));
                        ksv[jj] = kk[ii] * __expf(blast - bi);
                    }
                    ksw[i >> 1] = pkbf(ksv[0], ksv[1]);
                }
                *(LAS u32x4*)(KST + d * SC_TP + 8 * quad) = (u32x4){ksw[0], ksw[1], ksw[2], ksw[3]};
                if (quad == 0) DEC[d] = __expf(blast);
                const int cv = dir ? 31 - vp : vp;
                LAS bf16_t* vd = VT + (vch * 8) * SC_TP + cv;
                vd[0 * SC_TP] = (bf16_t)(vreg.x & 0xffffu); vd[1 * SC_TP] = (bf16_t)(vreg.x >> 16); vd[2 * SC_TP] = (bf16_t)(vreg.y & 0xffffu); vd[3 * SC_TP] = (bf16_t)(vreg.y >> 16);
                vd[4 * SC_TP] = (bf16_t)(vreg.z & 0xffffu); vd[5 * SC_TP] = (bf16_t)(vreg.z >> 16); vd[6 * SC_TP] = (bf16_t)(vreg.w & 0xffffu); vd[7 * SC_TP] = (bf16_t)(vreg.w >> 16);
            }
            if (n + 1 < 136) SC_LOAD(n + 1);
            __syncthreads();
            if (w < 4) {
                const int ct = w >> 1, st = w & 1;
                f32x4 sc = {0.f, 0.f, 0.f, 0.f};
                if (st <= ct) {
#pragma unroll
                    for (int k4 = 0; k4 < 4; ++k4) {
                        const bf16x8 av = *(const LAS bf16x8*)(QA + (16 * ct + d16) * SC_QP + 32 * k4 + 8 * quad);
                        const bf16x8 bv = *(const LAS bf16x8*)(KA + (16 * st + d16) * SC_QP + 32 * k4 + 8 * quad);
                        sc = __builtin_amdgcn_mfma_f32_16x16x32_bf16(av, bv, sc, 0, 0, 0);
                    }
                }
#pragma unroll
                for (int r = 0; r < 4; ++r) { const int cc = 16 * ct + 4 * quad + r, ss = 16 * st + d16; PM[cc * SC_TP + ss] = f2bf1(ss <= cc ? sc[r] : 0.f); }
            }
            f32x4 O0 = {0.f, 0.f, 0.f, 0.f}, O1 = {0.f, 0.f, 0.f, 0.f};
#pragma unroll
            for (int k4 = 0; k4 < 4; ++k4) {
                u32x4 bw; bw.x = pkbf(S[2 * k4][0], S[2 * k4][1]); bw.y = pkbf(S[2 * k4][2], S[2 * k4][3]); bw.z = pkbf(S[2 * k4 + 1][0], S[2 * k4 + 1][1]); bw.w = pkbf(S[2 * k4 + 1][2], S[2 * k4 + 1][3]);
                const bf16x8 bv = __builtin_bit_cast(bf16x8, bw);
                {
                    const LAS bf16_t* ap = QI + d16 * SC_QP + 32 * k4 + 4 * quad;
                    u32x4 aw; const u32x2 lo = *(const LAS u32x2*)ap, hh = *(const LAS u32x2*)(ap + 16); aw.x = lo.x; aw.y = lo.y; aw.z = hh.x; aw.w = hh.y;
                    O0 = __builtin_amdgcn_mfma_f32_16x16x32_bf16(__builtin_bit_cast(bf16x8, aw), bv, O0, 0, 0, 0);
                }
                {
                    const LAS bf16_t* ap = QI + (16 + d16) * SC_QP + 32 * k4 + 4 * quad;
                    u32x4 aw; const u32x2 lo = *(const LAS u32x2*)ap, hh = *(const LAS u32x2*)(ap + 16); aw.x = lo.x; aw.y = lo.y; aw.z = hh.x; aw.w = hh.y;
                    O1 = __builtin_amdgcn_mfma_f32_16x16x32_bf16(__builtin_bit_cast(bf16x8, aw), bv, O1, 0, 0, 0);
                }
            }
            __syncthreads();
            const bf16x8 vB = *(const LAS bf16x8*)(VT + (16 * w + d16) * SC_TP + 8 * quad);
            O0 = __builtin_amdgcn_mfma_f32_16x16x32_bf16(*(const LAS bf16x8*)(PM + d16 * SC_TP + 8 * quad), vB, O0, 0, 0, 0);
            O1 = __builtin_amdgcn_mfma_f32_16x16x32_bf16(*(const LAS bf16x8*)(PM + (16 + d16) * SC_TP + 8 * quad), vB, O1, 0, 0, 0);
#pragma unroll
            for (int r = 0; r < 4; ++r) {
                const int c0 = 4 * quad + r, c1 = 16 + c0;
                P[(size_t)(rb + (dir ? 31 - c0 : c0)) * NCC + zcol + 16 * w + d16] = f2bf1(O0[r]);
                P[(size_t)(rb + (dir ? 31 - c1 : c1)) * NCC + zcol + 16 * w + d16] = f2bf1(O1[r]);
            }
#pragma unroll
            for (int dt = 0; dt < 8; ++dt) {
                const f32x4 dc = *(const LAS f32x4*)(DEC + 16 * dt + 4 * quad);
                const bf16x8 kA = *(const LAS bf16x8*)(KST + (16 * dt + d16) * SC_TP + 8 * quad);
                S[dt] = __builtin_amdgcn_mfma_f32_16x16x32_bf16(kA, vB, S[dt] * dc, 0, 0, 0);
            }
        }
#undef SC_LOAD
#undef SC_ROWBASE
        __syncthreads();
    }
}
__device__ __forceinline__ void readout_phase(const bf16_t* __restrict__ P, const float* __restrict__ gn, bf16_t* __restrict__ U, int mrows, int tid, int bid, int G) {
    const long total = (long)mrows * 128;
    for (long idx = (long)bid * NTHR + tid; idx < total; idx += (long)G * NTHR) {
        const int ch = (int)(idx & 15), h = (int)((idx >> 4) & 7); const int m = (int)(idx >> 7);
        const bf16_t* pr = P + (size_t)m * NCC + h * 128 + ch * 8;
        const u32x4 of = *(const u32x4*)(pr + 1024), ob = *(const u32x4*)(pr + 2048), gg = *(const u32x4*)(pr + 4096);
        float o[8];
        o[0] = bflo(of.x) + bflo(ob.x); o[1] = bfhi(of.x) + bfhi(ob.x); o[2] = bflo(of.y) + bflo(ob.y); o[3] = bfhi(of.y) + bfhi(ob.y);
        o[4] = bflo(of.z) + bflo(ob.z); o[5] = bfhi(of.z) + bfhi(ob.z); o[6] = bflo(of.w) + bflo(ob.w); o[7] = bfhi(of.w) + bfhi(ob.w);
        float ss = 0.f;
#pragma unroll
        for (int j = 0; j < 8; ++j) ss += o[j] * o[j];
        ss += __shfl_xor(ss, 1); ss += __shfl_xor(ss, 2); ss += __shfl_xor(ss, 4); ss += __shfl_xor(ss, 8);
        const float rs = 1.f / sqrtf(ss * (1.f / 128.f) + RMS_EPS);
        const f32x4 g0 = *(const f32x4*)(gn + ch * 8), g1 = *(const f32x4*)(gn + ch * 8 + 4);
        u32x4 wv;
        wv.x = pkbf(o[0] * rs * g0[0] * silu_f(bflo(gg.x)), o[1] * rs * g0[1] * silu_f(bfhi(gg.x)));
        wv.y = pkbf(o[2] * rs * g0[2] * silu_f(bflo(gg.y)), o[3] * rs * g0[3] * silu_f(bfhi(gg.y)));
        wv.z = pkbf(o[4] * rs * g1[0] * silu_f(bflo(gg.z)), o[5] * rs * g1[1] * silu_f(bfhi(gg.z)));
        wv.w = pkbf(o[6] * rs * g1[2] * silu_f(bflo(gg.w)), o[7] * rs * g1[3] * silu_f(bfhi(gg.w)));
        *(u32x4*)(U + (size_t)m * DM + h * 128 + ch * 8) = wv;
    }
}

__global__ void __launch_bounds__(NTHR, 2) fwd_megakernel(Args a) {
    extern __shared__ __attribute__((aligned(16))) unsigned char lds_raw[];
    LAS unsigned char* lds = (LAS unsigned char*)lds_raw;
    cg::grid_group grid = cg::this_grid();
    const int tid0 = threadIdx.x, bid = blockIdx.x, G = gridDim.x;
#define FRESH_TID() int tid = tid0; asm volatile("" : "+v"(tid))
    bf16_t* HU = (bf16_t*)(a.ws + WS_HU);
    bf16_t* PROJ = (bf16_t*)(a.ws + WS_PROJ);
    float* VPRE = (float*)(a.ws + WS_PROJ);
    const float* mod = (const float*)(a.ws + WS_MOD);
    { FRESH_TID(); prologue_a(a, lds, tid, bid, G); }
    grid.sync();
    { FRESH_TID(); prologue_b(a, tid, bid, G); }
    grid.sync();
#pragma nounroll
    for (int l = 0; l < DEPTH; ++l) {
        const int j = l >> 1;
        const int mrows = (l == DEPTH - 1) ? MLAT : MTOT;
        if ((l & 1) == 0) {
            { pg8::Gemm g{HU, (const bf16_t*)(a.ws + WS_WINAB) + (size_t)j * NAB * DM, MTOT, NAB, DM}; pg8::StaticOrder S; S.init(MTOT, NAB, G, bid);
              EpiAB E{PROJ, (const float*)(a.ws + WS_ROPE)};
              pg8::gemm_phase<EpiAB, pg8::StaticOrder, PG8_ALIGN, PG8_SP2>(lds, g, S, E); }
            grid.sync();
            { FRESH_TID(); attn_phase(lds, PROJ, a.sink_ab + j * 8, HU, tid, bid, G); }
            { FRESH_TID(); conv_phase(PROJ, a.conv_ab + j * 3 * 512, HU, tid, bid, G); }
            grid.sync();
        } else {
            { pg8::Gemm g{HU, (const bf16_t*)(a.ws + WS_WINC) + (size_t)j * NCC * DM, MTOT, NCC, DM}; pg8::StaticOrder S; S.init(MTOT, NCC, G, bid);
              EpiC E{PROJ};
              pg8::gemm_phase<EpiC, pg8::StaticOrder, PG8_ALIGN, PG8_SP2>(lds, g, S, E); }
            grid.sync();
            { FRESH_TID(); scan_phase(lds, PROJ, (const float*)(a.ws + WS_LB) + j * 1024, tid, bid, G); }
            grid.sync();
            { FRESH_TID(); readout_phase(PROJ, a.gnorm_c + j * 128, HU, mrows, tid, bid, G); }
            grid.sync();
        }
        { const bf16_t* wo = (l & 1) ? (const bf16_t*)(a.ws + WS_WOUTC) + (size_t)j * DM * DM : (const bf16_t*)(a.ws + WS_WOUTAB) + (size_t)j * DM * DM;
          pg8::Gemm g{HU, wo, mrows, DM, DM}; pg8::StaticOrder S; S.init(mrows, DM, G, bid);
          EpiOut E{l == 0 ? a.x : a.out, l == 0 ? a.ctx : (const float*)(a.ws + WS_XC), mod + (size_t)l * 9 * 3072 + 2048, VPRE};
          pg8::gemm_phase<EpiOut, pg8::StaticOrder, PG8_ALIGN, PG8_SP2>(lds, g, S, E); }
        grid.sync();
        { FRESH_TID(); ln_phase(a, l, mrows, tid, bid, G); }
        if (l < DEPTH - 1) grid.sync();
    }
}

extern "C" void kernel_launch(void* const* d_in, const int* in_sizes, int n_in, void* d_out, int out_size, void* d_ws, size_t ws_size, hipStream_t stream) {
    static int grid_blocks = 0;
    if (grid_blocks == 0) {
        if (n_in != 16 || ws_size < WS_END) { fprintf(stderr, "kernel_launch: unexpected n_in %d / ws_size %zu\n", n_in, ws_size); grid_blocks = -1; return; }
        int dev = 0, cus = 0, per_cu = 0;
        hipGetDevice(&dev);
        hipDeviceGetAttribute(&cus, hipDeviceAttributeMultiprocessorCount, dev);
        if (hipFuncSetAttribute((const void*)fwd_megakernel, hipFuncAttributeMaxDynamicSharedMemorySize, LDS_BYTES) != hipSuccess) { fprintf(stderr, "kernel_launch: hipFuncSetAttribute failed\n"); grid_blocks = -1; return; }
        if (hipOccupancyMaxActiveBlocksPerMultiprocessor(&per_cu, (const void*)fwd_megakernel, NTHR, LDS_BYTES) != hipSuccess || per_cu < 1) { fprintf(stderr, "kernel_launch: occupancy query gave %d\n", per_cu); per_cu = 1; }
        (void)hipGetLastError();
        grid_blocks = cus * per_cu;
        fprintf(stderr, "kernel_launch: cus %d per_cu %d grid %d ws %zu\n", cus, per_cu, grid_blocks, ws_size);
    }
    if (grid_blocks < 0) return;
    Args a{};
    a.x = (const float*)d_in[0]; a.c = (const float*)d_in[1]; a.ctx = (const float*)d_in[2]; a.c_ctx = (const float*)d_in[3]; a.w_ada = (const float*)d_in[4]; a.b_ada = (const float*)d_in[5];
    a.ln_g = (const float*)d_in[6]; a.ln_b = (const float*)d_in[7]; a.w_in_ab = (const float*)d_in[8]; a.w_out_ab = (const float*)d_in[9]; a.sink_ab = (const float*)d_in[10]; a.conv_ab = (const float*)d_in[11];
    a.w_in_c = (const float*)d_in[12]; a.w_out_c = (const float*)d_in[13]; a.lb_c = (const float*)d_in[14]; a.gnorm_c = (const float*)d_in[15];
    a.out = (float*)d_out; a.ws = (unsigned char*)d_ws;
    void* args[] = {&a};
    hipError_t e = hipLaunchCooperativeKernel((const void*)fwd_megakernel, dim3(grid_blocks), dim3(NTHR), args, LDS_BYTES, stream);
    if (e != hipSuccess) fprintf(stderr, "kernel_launch: cooperative launch failed: %s (grid %d)\n", hipGetErrorString(e), grid_blocks);
}
```

```cpp
#include <hip/hip_runtime.h>
#include <hip/hip_cooperative_groups.h>
#include <cstdio>
#include <cstdint>
namespace cg = cooperative_groups;
namespace pg8 {
#define PG8_LAS __attribute__((address_space(3)))
typedef unsigned short bf16_t;
typedef short bf16x8 __attribute__((ext_vector_type(8)));
typedef float f32x4 __attribute__((ext_vector_type(4)));
typedef unsigned u32x4 __attribute__((ext_vector_type(4)));
constexpr int BM = 256, BK = 64, HALF = 128, HTB = HALF * BK * 2  , STAGE_BYTES = 8 * HTB, NXCD = 8, WGM = 8;

__host__ __device__ __forceinline__ int lds_byte(int r, int c) { const int st = (r >> 4) * 2 + (c >> 5), rr = r & 15, cc = c & 31, ob = rr * 64 + cc * 2; return st * 1024 + (ob ^ (((ob >> 9) & 1) << 5)); }
__host__ __device__ __forceinline__ void stage_rc(int b, int& R, int& C) { const int st = b / 1024, sb = b % 1024, swz = sb ^ (((sb >> 9) & 1) << 5); R = (st >> 1) * 16 + swz / 64; C = (st & 1) * 32 + (swz % 64) / 2; }
__host__ __device__ __forceinline__ int perm32(int rho) { const int n = rho >> 4, i = rho & 15; return 8 * (i >> 2) + 4 * n + (i & 3); }

struct Unit { int pm, pn; };
struct Gemm { const bf16_t* A; const bf16_t* Bt; int M, N, K; };

struct StaticOrder {
    int nM, nN, nwg, G, c;
    __host__ __device__ void init(int M, int N, int G_, int c_) { nM = M / BM; nN = N / BM; nwg = nM * nN; G = G_; c = c_; }
    __host__ __device__ bool next(int i, Unit& u) const {
        const long L = (long)i * G + c; if (L >= nwg) return false;
        int wgid = (int)L; { const int q = nwg / NXCD, r = nwg % NXCD, xcd = wgid % NXCD, off = wgid / NXCD; wgid = (xcd < r ? xcd * (q + 1) : r * (q + 1) + (xcd - r) * q) + off; }
        const int nig = WGM * nN, gid = wgid / nig, fm = gid * WGM, gsz = (nM - fm) < WGM ? (nM - fm) : WGM;
        u.pm = fm + ((wgid % nig) % gsz); u.pn = (wgid % nig) / gsz; return true;
    }
    __device__ __forceinline__ void a_ready(const Unit&) const {}
    __device__ __forceinline__ void done(const Unit&) const {}
};

template <class Epi, class Sched, bool ALIGN_EPI = false, bool SP2 = false>
__device__ __forceinline__ void gemm_phase(PG8_LAS unsigned char* lds, const Gemm g, const Sched& S, const Epi& E) {
    const int tid = threadIdx.x, wid = __builtin_amdgcn_readfirstlane(tid >> 6), lane = tid & 63, wr = wid >> 2, wc = wid & 3, fr = lane & 15, fq = lane >> 4;
    const int K = g.K, nt = K / BK;
    unsigned voffA[2], voffB[2];
#pragma unroll
    for (int i = 0; i < 2; ++i) { int R, C; stage_rc(tid * 16 + i * 8192, R, C); const int Rb = Epi::PERM ? ((R & ~31) + perm32(R & 31)) : R;
        voffA[i] = (unsigned)(R * K + C) * 2u; voffB[i] = (unsigned)(Rb * K + C) * 2u; }
    const size_t kstep = (size_t)(BK * 2);
    const size_t hstep = (size_t)HALF * K * 2;
    const size_t tstep = 2 * hstep;
    const unsigned ldsw = (unsigned)wid * 1024u;
    const int aoff = lds_byte(wr * 64 + fr, fq * 8), boff = lds_byte(wc * 32 + fr, fq * 8);
#define PG8_SA(b, h) (((b) * 2 + (h)) * HTB)
#define PG8_SB(b, h) ((4 + (b) * 2 + (h)) * HTB)
#define PG8_STAGE(bufoff, gbase, voff) do { _Pragma("unroll") for (int _i = 0; _i < 2; ++_i) \
        __builtin_amdgcn_global_load_lds((const unsigned*)((const char*)(gbase) + (voff)[_i]), (PG8_LAS unsigned*)(lds + (bufoff) + ldsw + _i * 8192), 16, 0, 0); } while (0)
#define PG8_LDA(dst, b, h) do { _Pragma("unroll") for (int m = 0; m < 4; ++m) _Pragma("unroll") for (int k = 0; k < 2; ++k) dst[m][k] = *(const PG8_LAS bf16x8*)(lds + PG8_SA(b, h) + aoff + m * 2048 + k * 1024); } while (0)
#define PG8_LDB(dst, b, h) do { _Pragma("unroll") for (int n = 0; n < 2; ++n) _Pragma("unroll") for (int k = 0; k < 2; ++k) dst[n][k] = *(const PG8_LAS bf16x8*)(lds + PG8_SB(b, h) + boff + n * 2048 + k * 1024); } while (0)
#define PG8_MMA(ai, bj, At, Bt) do { __builtin_amdgcn_s_setprio(1); _Pragma("unroll") for (int m = 0; m < 4; ++m) _Pragma("unroll") for (int n = 0; n < 2; ++n) _Pragma("unroll") for (int k = 0; k < 2; ++k) \
        acc[ai][bj][m][n] = __builtin_amdgcn_mfma_f32_16x16x32_bf16(Bt[n][k], At[m][k], acc[ai][bj][m][n], 0, 0, 0); __builtin_amdgcn_s_setprio(0); } while (0)
#define PG8_WAIT_V(n) asm volatile("s_waitcnt vmcnt(" #n ")" ::: "memory")
#define PG8_WAIT_L(n) asm volatile("s_waitcnt lgkmcnt(" #n ")" ::: "memory")
#define PG8_BAR __builtin_amdgcn_s_barrier()
#define PG8_SCHED __builtin_amdgcn_sched_barrier(0)
    Unit cur, nxt; int ui = 0;
    if (!S.next(0, cur)) return;
    f32x4 acc[2][2][4][2];
#pragma unroll
    for (int a = 0; a < 2; ++a)
#pragma unroll
        for (int b = 0; b < 2; ++b)
#pragma unroll
            for (int m = 0; m < 4; ++m)
#pragma unroll
                for (int n = 0; n < 2; ++n) acc[a][b][m][n] = (f32x4){0.f, 0.f, 0.f, 0.f};
    bf16x8 At[4][2], B0[2][2], B1[2][2];
    const char* cA = (const char*)g.A + (size_t)cur.pm * tstep; const char* cB = (const char*)g.Bt + (size_t)cur.pn * tstep;
    S.a_ready(cur);
    if constexpr (SP2) {
        PG8_STAGE(PG8_SB(0, 0), cB, voffB); PG8_STAGE(PG8_SB(0, 1), cB + hstep, voffB); PG8_STAGE(PG8_SA(0, 0), cA, voffA); PG8_STAGE(PG8_SA(0, 1), cA + hstep, voffA);
        if (wr == 1) PG8_BAR;
        PG8_WAIT_V(2); PG8_BAR;
        PG8_STAGE(PG8_SB(1, 0), cB + kstep, voffB); PG8_STAGE(PG8_SA(1, 0), cA + kstep, voffA); PG8_STAGE(PG8_SB(1, 1), cB + hstep + kstep, voffB);
        PG8_WAIT_V(6); PG8_BAR;
    } else {
        PG8_STAGE(PG8_SB(0, 0), cB, voffB); PG8_STAGE(PG8_SA(0, 0), cA, voffA); PG8_STAGE(PG8_SB(0, 1), cB + hstep, voffB); PG8_STAGE(PG8_SA(0, 1), cA + hstep, voffA);
        if (wr == 1) PG8_BAR;
        PG8_WAIT_V(4); PG8_BAR;
        PG8_STAGE(PG8_SB(1, 0), cB + kstep, voffB); PG8_STAGE(PG8_SA(1, 0), cA + kstep, voffA); PG8_STAGE(PG8_SB(1, 1), cB + hstep + kstep, voffB);
        PG8_WAIT_V(6); PG8_BAR;
    }
    for (;;) {
        const bool has_next = S.next(ui + 1, nxt);
        const char* nA = has_next ? (const char*)g.A + (size_t)nxt.pm * tstep : cA; const char* nB = has_next ? (const char*)g.Bt + (size_t)nxt.pn * tstep : cB;
        for (int t = 0; t < nt; t += 2) {
            const bool last = (t == nt - 2);
            const char* a1 = cA + (size_t)(t + 1) * kstep;
            const char* a2 = last ? nA : cA + (size_t)(t + 2) * kstep; const char* b2 = last ? nB : cB + (size_t)(t + 2) * kstep;
            const char* a3 = a2 + kstep; const char* b3 = b2 + kstep;
            if (last && has_next) S.a_ready(nxt);
            if constexpr (SP2) {
            PG8_LDB(B0, 0, 0); PG8_LDB(B1, 0, 1); PG8_SCHED; PG8_LDA(At, 0, 0); PG8_STAGE(PG8_SA(1, 1), a1 + hstep, voffA);
            PG8_WAIT_V(8); PG8_WAIT_L(0); PG8_BAR; PG8_MMA(0, 0, At, B0); PG8_MMA(0, 1, At, B1); PG8_BAR; PG8_SCHED;
            PG8_LDA(At, 0, 1); PG8_STAGE(PG8_SB(0, 0), b2, voffB); PG8_STAGE(PG8_SB(0, 1), b2 + hstep, voffB); PG8_STAGE(PG8_SA(0, 0), a2, voffA);
            PG8_WAIT_V(8); PG8_WAIT_L(0); PG8_BAR; PG8_MMA(1, 0, At, B0); PG8_MMA(1, 1, At, B1); PG8_BAR; PG8_SCHED;
            PG8_LDB(B0, 1, 0); PG8_LDB(B1, 1, 1); PG8_SCHED; PG8_LDA(At, 1, 0); PG8_STAGE(PG8_SA(0, 1), a2 + hstep, voffA);
            PG8_WAIT_V(8); PG8_WAIT_L(0); PG8_BAR; PG8_MMA(0, 0, At, B0); PG8_MMA(0, 1, At, B1); PG8_BAR; PG8_SCHED;
            PG8_LDA(At, 1, 1); PG8_STAGE(PG8_SB(1, 0), b3, voffB); PG8_STAGE(PG8_SB(1, 1), b3 + hstep, voffB); PG8_STAGE(PG8_SA(1, 0), a3, voffA);
            PG8_WAIT_V(8); PG8_WAIT_L(0); PG8_BAR; PG8_MMA(1, 0, At, B0); PG8_MMA(1, 1, At, B1); PG8_BAR; PG8_SCHED;
            } else {
            PG8_LDB(B0, 0, 0); PG8_SCHED; PG8_LDA(At, 0, 0); PG8_STAGE(PG8_SA(1, 1), a1 + hstep, voffA);
            PG8_WAIT_L(8); PG8_BAR; PG8_WAIT_L(0); PG8_MMA(0, 0, At, B0); PG8_BAR; PG8_SCHED;
            PG8_LDB(B1, 0, 1); PG8_STAGE(PG8_SB(0, 0), b2, voffB);
            PG8_BAR; PG8_WAIT_L(0); PG8_MMA(0, 1, At, B1); PG8_BAR;
            PG8_LDA(At, 0, 1); PG8_STAGE(PG8_SA(0, 0), a2, voffA);
            PG8_BAR; PG8_WAIT_L(0); PG8_MMA(1, 0, At, B0); PG8_BAR; PG8_SCHED;
            PG8_STAGE(PG8_SB(0, 1), b2 + hstep, voffB);
            PG8_WAIT_V(6); PG8_BAR; PG8_MMA(1, 1, At, B1); PG8_BAR;
            PG8_LDB(B0, 1, 0); PG8_SCHED; PG8_LDA(At, 1, 0); PG8_STAGE(PG8_SA(0, 1), a2 + hstep, voffA);
            PG8_WAIT_L(8); PG8_BAR; PG8_WAIT_L(0); PG8_MMA(0, 0, At, B0); PG8_BAR; PG8_SCHED;
            PG8_LDB(B1, 1, 1); PG8_STAGE(PG8_SB(1, 0), b3, voffB);
            PG8_BAR; PG8_WAIT_L(0); PG8_MMA(0, 1, At, B1); PG8_BAR;
            PG8_LDA(At, 1, 1); PG8_STAGE(PG8_SA(1, 0), a3, voffA);
            PG8_BAR; PG8_WAIT_L(0); PG8_MMA(1, 0, At, B0); PG8_BAR; PG8_SCHED;
            PG8_STAGE(PG8_SB(1, 1), b3 + hstep, voffB);
            PG8_WAIT_V(6); PG8_BAR; PG8_MMA(1, 1, At, B1); PG8_BAR;
            }
        }
        if constexpr (ALIGN_EPI) { if (wr == 0) PG8_BAR; }
        if constexpr (!Epi::AFTER_DRAIN) { E(acc, cur, wr, wc, fr, fq); S.done(cur); }
        if (!has_next) break;
#pragma unroll
        for (int a = 0; a < 2; ++a)
#pragma unroll
            for (int b = 0; b < 2; ++b)
#pragma unroll
                for (int m = 0; m < 4; ++m)
#pragma unroll
                    for (int n = 0; n < 2; ++n) acc[a][b][m][n] = (f32x4){0.f, 0.f, 0.f, 0.f};
        cur = nxt; cA = nA; cB = nB; ++ui;
        if constexpr (ALIGN_EPI) { if (wr == 1) PG8_BAR; }
    }
    PG8_WAIT_V(0);
    if constexpr (!ALIGN_EPI) { if (wr == 0) PG8_BAR; }
    PG8_BAR;
    if constexpr (Epi::AFTER_DRAIN) { E.fused(acc, cur, wr, wc, fr, fq, lds, wid, lane); S.done(cur); }
#undef PG8_SA
#undef PG8_SB
#undef PG8_STAGE
#undef PG8_LDA
#undef PG8_LDB
#undef PG8_MMA
#undef PG8_WAIT_V
#undef PG8_WAIT_L
#undef PG8_BAR
#undef PG8_SCHED
}
}

#ifndef PG8_SP2
#define PG8_SP2 true
#endif
#ifndef PG8_ALIGN
#define PG8_ALIGN true
#endif

constexpr int DM = 1024, NB = 8, SEQ = 4096, CTXL = 256, DEPTH = 4;
constexpr int MLAT = NB * SEQ, MCTX = NB * CTXL, MTOT = MLAT + MCTX;
constexpr int NAB = 3328, NCC = 5120;
constexpr float LN_EPS = 1e-5f, RMS_EPS = 1e-6f;
constexpr float DN_ALPHA = 1.681792830507429f;
constexpr float QSCALE = 0.125f * 1.4426950408889634f;
constexpr float LOG2E = 1.4426950408889634f;
constexpr int NWAVES = 8, NTHR = 512;

constexpr size_t MiB = 1u << 20;
constexpr size_t WS_WINAB = 1 * MiB, WS_WOUTAB = 14 * MiB, WS_WINC = 18 * MiB, WS_WOUTC = 38 * MiB;
constexpr size_t WS_MOD = 42 * MiB, WS_LB = 42 * MiB + 512 * 1024, WS_ROPE = 42 * MiB + 640 * 1024;
constexpr size_t WS_XC = 44 * MiB;
constexpr size_t WS_HU = 52 * MiB;
constexpr size_t WS_PROJ = 120 * MiB;
constexpr size_t WS_END = 460 * MiB;
constexpr int LDS_BYTES = 147456;

#define LAS __attribute__((address_space(3)))
typedef unsigned short bf16_t;
typedef short bf16x8 __attribute__((ext_vector_type(8)));
typedef float f32x4 __attribute__((ext_vector_type(4)));
typedef float f32x16 __attribute__((ext_vector_type(16)));
typedef unsigned u32x4 __attribute__((ext_vector_type(4)));
typedef unsigned u32x2 __attribute__((ext_vector_type(2)));
typedef float f32x2_t __attribute__((ext_vector_type(2)));
typedef __bf16 bf16x2_t __attribute__((ext_vector_type(2)));
typedef _Float16 f16x2_t __attribute__((ext_vector_type(2)));

__device__ __forceinline__ unsigned pkbf(float lo, float hi) { f32x2_t v = {lo, hi}; bf16x2_t b = __builtin_convertvector(v, bf16x2_t); return __builtin_bit_cast(unsigned, b); }
__device__ __forceinline__ unsigned pkh(float lo, float hi) { f32x2_t v = {lo, hi}; f16x2_t b = __builtin_convertvector(v, f16x2_t); return __builtin_bit_cast(unsigned, b); }
__device__ __forceinline__ unsigned short f2bf1(float f) { return (unsigned short)(pkbf(f, 0.f) & 0xffffu); }
__device__ __forceinline__ float bf2f(unsigned short u) { return __uint_as_float((unsigned)u << 16); }
__device__ __forceinline__ float bflo(unsigned u) { return __uint_as_float(u << 16); }
__device__ __forceinline__ float bfhi(unsigned u) { return __uint_as_float(u & 0xffff0000u); }
__device__ __forceinline__ float h2f(unsigned short u) { return (float)__builtin_bit_cast(_Float16, u); }
__device__ __forceinline__ float silu_f(float x) { return x / (1.f + __expf(-x)); }
__device__ __forceinline__ float wave_sum(float v) {
#pragma unroll
    for (int o = 1; o < 64; o <<= 1) v += __shfl_xor(v, o);
    return v;
}

#define XB_TMO      128
#define XB_XCNT(j)  (256  + 64 * (j))
#define XB_XSUB(j)  (1280 + 64 * (j))
#define XB_XGEN(j)  (2304 + 64 * (j))
#define XB_TOP      3328
#define XB_TOPGEN   3392
#define XCD_BAR_WORDS 3456
#define XB_SPIN_CAP (1u << 18)

__device__ __forceinline__ unsigned xb_ld(unsigned* p)              { return __hip_atomic_load(p, __ATOMIC_RELAXED, __HIP_MEMORY_SCOPE_AGENT); }
__device__ __forceinline__ unsigned xb_add(unsigned* p, unsigned v) { return __hip_atomic_fetch_add(p, v, __ATOMIC_RELAXED, __HIP_MEMORY_SCOPE_AGENT); }
__device__ __forceinline__ unsigned xb_xcc_id() { return (unsigned)__builtin_amdgcn_s_getreg((3 << 11) | 20) & 0xFu; }
#define XB_SPIN(cond, bar) do { unsigned _sp = 0; while (cond) { __builtin_amdgcn_s_sleep(1); \
    if ((++_sp & 255u) == 0u) { if (xb_ld(&(bar)[XB_TMO])) break; if (_sp > XB_SPIN_CAP) { atomicAdd(&(bar)[XB_TMO], 1u); break; } } } } while (0)

struct XcdBarrier {
    unsigned* bar; unsigned x;
    volatile LAS unsigned* st;
};

__device__ __forceinline__ XcdBarrier xcd_barrier_post(unsigned* bar, volatile LAS unsigned* st) {
    XcdBarrier b; b.bar = bar; b.x = xb_xcc_id(); b.st = st;
    if (threadIdx.x == 0) (void)xb_add(&bar[XB_XCNT(b.x)], 1u);
    return b;
}
__device__ __forceinline__ void xcd_barrier_complete(unsigned* bar, unsigned x, unsigned& nloc, unsigned& nx) {
    const unsigned G = gridDim.x * gridDim.y * gridDim.z;
    unsigned sum, cnt, mine, sp = 0u;
    for (;;) {
        sum = 0u; cnt = 0u; mine = 0u;
#pragma unroll
        for (unsigned j = 0; j < 16; ++j) { const unsigned c = xb_ld(&bar[XB_XCNT(j)]); sum += c; cnt += (c > 0u) ? 1u : 0u; mine = (j == x) ? c : mine; }
        if (sum == G) break;
        __builtin_amdgcn_s_sleep(1);
        if ((++sp & 255u) == 0u) { if (xb_ld(&bar[XB_TMO])) break; if (sp > XB_SPIN_CAP) { atomicAdd(&bar[XB_TMO], 1u); break; } }
    }
    nloc = mine > 0u ? mine : 1u; nx = cnt > 0u ? cnt : 1u;
}

__device__ __forceinline__ void xcd_barrier(const XcdBarrier& b) {
    asm volatile("s_waitcnt vmcnt(0)" ::: "memory");
    __syncthreads();
    if (threadIdx.x == 0) {
        unsigned* bar = b.bar;
        __builtin_amdgcn_s_waitcnt(0);
        unsigned nloc = b.st[0], nx = b.st[1];
        if (nloc == 0u) { xcd_barrier_complete(bar, b.x, nloc, nx); b.st[0] = nloc; b.st[1] = nx; }
        const unsigned old = xb_add(&bar[XB_XSUB(b.x)], 1u);
        const unsigned gen = old / nloc;
        if (old + 1u == (gen + 1u) * nloc) {
            __builtin_amdgcn_fence(__ATOMIC_RELEASE, "agent");
            asm volatile("s_waitcnt vmcnt(0)" ::: "memory");
            const unsigned og = xb_add(&bar[XB_TOP], 1u);
            const unsigned tg = og / nx;
            if (og + 1u == (tg + 1u) * nx) xb_add(&bar[XB_TOPGEN], 1u);
            else XB_SPIN(xb_ld(&bar[XB_TOPGEN]) == tg, bar);
            __builtin_amdgcn_fence(__ATOMIC_ACQUIRE, "agent");
            xb_add(&bar[XB_XGEN(b.x)], 1u);
            asm volatile("s_waitcnt vmcnt(0)" ::: "memory");
        } else {
            XB_SPIN(xb_ld(&bar[XB_XGEN(b.x)]) == gen, bar);
            __builtin_amdgcn_fence(__ATOMIC_ACQUIRE, "agent");
            asm volatile("s_waitcnt vmcnt(0)" ::: "memory");
        }
    }
    __syncthreads();
}

struct EpiAB {
    static constexpr bool PERM = false, AFTER_DRAIN = false;
    bf16_t* P; const float* rope;
    __device__ __forceinline__ void operator()(const pg8::f32x4 (&acc)[2][2][4][2], const pg8::Unit& u, int wr_, int wc_, int fr_, int fq_) const {
        int t_ = threadIdx.x; asm volatile("" : "+v"(t_));
        const int wid_ = __builtin_amdgcn_readfirstlane(t_ >> 6), wr = wid_ >> 2, wc = wid_ & 3, fr = t_ & 15, fq = (t_ >> 4) & 3;
        const int row0 = u.pm * 256 + wr * 64 + fr;
        const int col0 = u.pn * 256 + wc * 32 + 4 * fq;
        const bool latent = u.pm < (MLAT / 256);
        const bool any_rope = latent && (u.pn <= 2);
#pragma unroll
        for (int ai = 0; ai < 2; ++ai)
#pragma unroll
            for (int m = 0; m < 4; ++m) {
                const int row = row0 + ai * 128 + m * 16;
                f32x4 cs0 = {1.f, 0.f, 1.f, 0.f}, cs1 = {1.f, 0.f, 1.f, 0.f};
                if (any_rope) {
                    const int t = row & (SEQ - 1); const int pos = (wc & 1) ? (t & 63) : (t >> 6);
                    const float* rp = rope + (pos * 16 + 4 * fq) * 2;
                    cs0 = *(const f32x4*)rp; cs1 = *(const f32x4*)(rp + 4);
                }
                bf16_t* rowp = P + (size_t)row * NAB + col0;
#pragma unroll
                for (int bj = 0; bj < 2; ++bj) {
                    const int colbase = u.pn * 256 + bj * 128;
                    f32x4 a = acc[ai][bj][m][0], b = acc[ai][bj][m][1];
                    if (latent && colbase < 640) {
                        f32x4 o1, o2;
                        o1[0] = a[0] * cs0[0] - b[0] * cs0[1]; o2[0] = a[0] * cs0[1] + b[0] * cs0[0];
                        o1[1] = a[1] * cs0[2] - b[1] * cs0[3]; o2[1] = a[1] * cs0[3] + b[1] * cs0[2];
                        o1[2] = a[2] * cs1[0] - b[2] * cs1[1]; o2[2] = a[2] * cs1[1] + b[2] * cs1[0];
                        o1[3] = a[3] * cs1[2] - b[3] * cs1[3]; o2[3] = a[3] * cs1[3] + b[3] * cs1[2];
                        a = o1; b = o2;
                    }
                    if (colbase < 512) { a = a * QSCALE; b = b * QSCALE; }
                    u32x2 w0, w1; w0.x = pkbf(a[0], a[1]); w0.y = pkbf(a[2], a[3]); w1.x = pkbf(b[0], b[1]); w1.y = pkbf(b[2], b[3]);
                    *(u32x2*)(rowp + bj * 128) = w0; *(u32x2*)(rowp + bj * 128 + 16) = w1;
                }
                asm volatile("" ::: "memory");
            }
    }
};
struct EpiC {
    static constexpr bool PERM = false, AFTER_DRAIN = false;
    bf16_t* P;
    __device__ __forceinline__ void operator()(const pg8::f32x4 (&acc)[2][2][4][2], const pg8::Unit& u, int wr_, int wc_, int fr_, int fq_) const {
        int t_ = threadIdx.x; asm volatile("" : "+v"(t_));
        const int wid_ = __builtin_amdgcn_readfirstlane(t_ >> 6), wr = wid_ >> 2, wc = wid_ & 3, fr = t_ & 15, fq = (t_ >> 4) & 3;
        const int row0 = u.pm * 256 + wr * 64 + fr;
        const int col0 = u.pn * 256 + wc * 32 + 4 * fq;
        const int type = u.pn >> 2;
#pragma unroll
        for (int ai = 0; ai < 2; ++ai)
#pragma unroll
            for (int m = 0; m < 4; ++m) {
                bf16_t* rowp = P + (size_t)(row0 + ai * 128 + m * 16) * NCC + col0;
#pragma unroll
                for (int bj = 0; bj < 2; ++bj)
#pragma unroll
                    for (int n = 0; n < 2; ++n) {
                        f32x4 v = acc[ai][bj][m][n]; u32x2 w;
                        if (type == 0) {
#pragma unroll
                            for (int j = 0; j < 4; ++j) v[j] = silu_f(v[j]) * 0.08838834764831845f;
                            w.x = pkbf(v[0], v[1]); w.y = pkbf(v[2], v[3]);
                        } else if (type == 1 || type == 2) { w.x = pkh(v[0], v[1]); w.y = pkh(v[2], v[3]); }
                        else { w.x = pkbf(v[0], v[1]); w.y = pkbf(v[2], v[3]); }
                        *(u32x2*)(rowp + bj * 128 + n * 16) = w;
                    }
            }
    }
};
struct EpiOut {
    static constexpr bool PERM = false, AFTER_DRAIN = false;
    const float* xlat; const float* xctx; const float* gate; float* V;
    __device__ __forceinline__ void operator()(const pg8::f32x4 (&acc)[2][2][4][2], const pg8::Unit& u, int wr_, int wc_, int fr_, int fq_) const {
        int t_ = threadIdx.x; asm volatile("" : "+v"(t_));
        const int wid_ = __builtin_amdgcn_readfirstlane(t_ >> 6), wr = wid_ >> 2, wc = wid_ & 3, fr = t_ & 15, fq = (t_ >> 4) & 3;
        const int row0 = u.pm * 256 + wr * 64 + fr;
        const int col0 = u.pn * 256 + wc * 32 + 4 * fq;
        const bool latent = u.pm < (MLAT / 256);
        const int mr = latent ? (u.pm >> 4) : 8;
        f32x4 g4[2][2];
#pragma unroll
        for (int bj = 0; bj < 2; ++bj)
#pragma unroll
            for (int n = 0; n < 2; ++n) g4[bj][n] = *(const f32x4*)(gate + (size_t)mr * 3072 + col0 + bj * 128 + n * 16);
#pragma unroll
        for (int ai = 0; ai < 2; ++ai)
#pragma unroll
            for (int m = 0; m < 4; ++m) {
                const int row = row0 + ai * 128 + m * 16;
                const float* xr = (latent ? xlat + (size_t)row * DM : xctx + (size_t)(row - MLAT) * DM) + col0;
                float* vr = V + (size_t)row * DM + col0;
#pragma unroll
                for (int bj = 0; bj < 2; ++bj)
#pragma unroll
                    for (int n = 0; n < 2; ++n) {
                        const f32x4 x4 = *(const f32x4*)(xr + bj * 128 + n * 16);
                        *(f32x4*)(vr + bj * 128 + n * 16) = x4 * DN_ALPHA + g4[bj][n] * acc[ai][bj][m][n];
                    }
            }
    }
};

__device__ __forceinline__ unsigned f2bf_bits(float f) { unsigned u = __builtin_bit_cast(unsigned, f); return (u + 0x7fffu + ((u >> 16) & 1u)) >> 16; }
__device__ __forceinline__ unsigned pk2(float lo, float hi) { return f2bf_bits(lo) | (f2bf_bits(hi) << 16); }
__device__ __forceinline__ void transpose_item(const float* W, int K, int N, bf16_t* WT, LAS float* scr, int item, int lane) {
    const int nblk = N / 32, kb = item / nblk, nb = item % nblk, k0 = 64 * kb, n0 = 32 * nb;
#pragma unroll 8
    for (int i = 0; i < 32; ++i) { const int kk = 2 * i + (lane >> 5); scr[kk * 33 + (lane & 31)] = W[(size_t)(k0 + kk) * N + n0 + (lane & 31)]; }
    asm volatile("s_waitcnt lgkmcnt(0)" ::: "memory");
    const int c = lane & 7;
#pragma unroll
    for (int j = 0; j < 4; ++j) { const int n = (lane >> 3) + 8 * j; const LAS float* s = scr + (8 * c) * 33 + n;
        u32x4 o; o.x = pk2(s[0 * 33], s[1 * 33]); o.y = pk2(s[2 * 33], s[3 * 33]); o.z = pk2(s[4 * 33], s[5 * 33]); o.w = pk2(s[6 * 33], s[7 * 33]);
        *(u32x4*)(WT + (size_t)(n0 + n) * K + k0 + 8 * c) = o; }
    asm volatile("s_waitcnt lgkmcnt(0)" ::: "memory");
}

struct Args {
    const float* x; const float* c; const float* ctx; const float* c_ctx; const float* w_ada; const float* b_ada; const float* ln_g; const float* ln_b;
    const float* w_in_ab; const float* w_out_ab; const float* sink_ab; const float* conv_ab; const float* w_in_c; const float* w_out_c; const float* lb_c; const float* gnorm_c;
    float* out; unsigned char* ws;
};

__device__ __forceinline__ void prologue_a(const Args& a, LAS unsigned char* lds, int tid, int bid, int G) {
    const int lane = tid & 63, wid = tid >> 6;
    float* mod = (float*)(a.ws + WS_MOD);
    for (int item = bid; item < 192; item += G) {
        const int l = item / 48, cgp = item % 48, col = cgp * 64 + lane;
        LAS float* s = (LAS float*)lds;
        for (int i = tid; i < 9 * 1024; i += NTHR) { const int r = i >> 10, k = i & 1023; const float cv = r < 8 ? a.c[r * 1024 + k] : a.c_ctx[k]; s[i] = silu_f(cv); }
        __syncthreads();
        const float* W = a.w_ada + (size_t)l * 1024 * 3072 + col;
        float acc[9];
#pragma unroll
        for (int r = 0; r < 9; ++r) acc[r] = 0.f;
        const int kbeg = wid * 128;
#pragma unroll 2
        for (int k = kbeg; k < kbeg + 128; k += 4) {
            const float w0 = W[(size_t)k * 3072], w1 = W[(size_t)(k + 1) * 3072], w2 = W[(size_t)(k + 2) * 3072], w3 = W[(size_t)(k + 3) * 3072];
#pragma unroll
            for (int r = 0; r < 9; ++r) { const f32x4 sv = *(const LAS f32x4*)(s + r * 1024 + k); acc[r] += sv[0] * w0 + sv[1] * w1 + sv[2] * w2 + sv[3] * w3; }
        }
        LAS float* red = (LAS float*)(lds + 40960);
#pragma unroll
        for (int r = 0; r < 9; ++r) red[(wid * 9 + r) * 64 + lane] = acc[r];
        __syncthreads();
        for (int t = tid; t < 576; t += NTHR) {
            const int r = t >> 6, cc = t & 63; float sum = 0.f;
#pragma unroll
            for (int w = 0; w < 8; ++w) sum += red[(w * 9 + r) * 64 + cc];
            mod[((size_t)l * 9 + r) * 3072 + cgp * 64 + cc] = sum + a.b_ada[l * 3072 + cgp * 64 + cc];
        }
        __syncthreads();
    }
    if (bid == G - 1) {
        float* lbv = (float*)(a.ws + WS_LB);
        for (int i = tid; i < 2048; i += NTHR) { const int d = i >> 10, cch = i & 1023; const float l0 = a.lb_c[(d * 2 + 0) * 1024 + cch], l1 = a.lb_c[(d * 2 + 1) * 1024 + cch];
            lbv[(d * 2 + 0) * 1024 + cch] = 0.f; lbv[(d * 2 + 1) * 1024 + cch] = 1.f / (1.f + __expf(l0 - l1)); }
    }
    if (bid == G - 2 || G == 1) {
        float* rp = (float*)(a.ws + WS_ROPE);
        for (int i = tid; i < 1024; i += NTHR) { const int pos = i >> 4, fi = i & 15; const float fr = exp2f(-(float)fi * (13.287712379549449f / 16.f)); const float ang = (float)pos * fr;
            rp[2 * i] = __cosf(ang); rp[2 * i + 1] = __sinf(ang); }
    }
    LAS float* scr = (LAS float*)(lds + wid * 16384);
    const int gw = bid * NWAVES + wid, NGW = G * NWAVES;
    constexpr int I_AB = 16 * (NAB / 32), I_O = 16 * 32, I_C = 16 * (NCC / 32);
    constexpr int NITEMS = 2 * (I_AB + I_O + I_C + I_O);
    for (int it = gw; it < NITEMS; it += NGW) {
        int r = it;
        if (r < 2 * I_AB) { const int j = r / I_AB; transpose_item(a.w_in_ab + (size_t)j * DM * NAB, DM, NAB, (bf16_t*)(a.ws + WS_WINAB) + (size_t)j * NAB * DM, scr, r % I_AB, lane); continue; } r -= 2 * I_AB;
        if (r < 2 * I_O) { const int j = r / I_O; transpose_item(a.w_out_ab + (size_t)j * DM * DM, DM, DM, (bf16_t*)(a.ws + WS_WOUTAB) + (size_t)j * DM * DM, scr, r % I_O, lane); continue; } r -= 2 * I_O;
        if (r < 2 * I_C) { const int j = r / I_C; transpose_item(a.w_in_c + (size_t)j * DM * NCC, DM, NCC, (bf16_t*)(a.ws + WS_WINC) + (size_t)j * NCC * DM, scr, r % I_C, lane); continue; } r -= 2 * I_C;
        { const int j = r / I_O; transpose_item(a.w_out_c + (size_t)j * DM * DM, DM, DM, (bf16_t*)(a.ws + WS_WOUTC) + (size_t)j * DM * DM, scr, r % I_O, lane); }
    }
}
__device__ __forceinline__ void prologue_b(const Args& a, int tid, int bid, int G) {
    const int lane = tid & 63, wid = tid >> 6;
    const float* mod = (const float*)(a.ws + WS_MOD);
    bf16_t* H = (bf16_t*)(a.ws + WS_HU);
    for (int m = bid * NWAVES + wid; m < MTOT; m += G * NWAVES) {
        const float* src = m < MLAT ? a.x + (size_t)m * DM : a.ctx + (size_t)(m - MLAT) * DM;
        const float* md = mod + (size_t)(m < MLAT ? (m >> 12) : 8) * 3072;
#pragma unroll
        for (int j = 0; j < 4; ++j) {
            const int cix = 4 * lane + 256 * j;
            const f32x4 v = *(const f32x4*)(src + cix), sh = *(const f32x4*)(md + cix), sc = *(const f32x4*)(md + 1024 + cix);
            const f32x4 o = v * (sc + 1.f) + sh;
            u32x2 w; w.x = pkbf(o[0], o[1]); w.y = pkbf(o[2], o[3]);
            *(u32x2*)(H + (size_t)m * DM + cix) = w;
        }
    }
}
__device__ __forceinline__ void ln_phase(const Args& a, int l, int mrows, int tid, int bid, int G) {
    const int lane = tid & 63, wid = tid >> 6;
    const float* V = (const float*)(a.ws + WS_PROJ);
    const float* mod = (const float*)(a.ws + WS_MOD) + (size_t)(l + 1) * 9 * 3072;
    float* XC = (float*)(a.ws + WS_XC);
    bf16_t* H = (bf16_t*)(a.ws + WS_HU);
    const float* gam = a.ln_g + l * DM; const float* bet = a.ln_b + l * DM;
    for (int m = bid * NWAVES + wid; m < mrows; m += G * NWAVES) {
        const float* vr = V + (size_t)m * DM;
        f32x4 v[4]; float s = 0.f;
#pragma unroll
        for (int j = 0; j < 4; ++j) { v[j] = *(const f32x4*)(vr + 4 * lane + 256 * j); s += (v[j][0] + v[j][1]) + (v[j][2] + v[j][3]); }
        const float mean = wave_sum(s) * (1.f / DM); float s2 = 0.f;
#pragma unroll
        for (int j = 0; j < 4; ++j) { v[j] = v[j] - mean; s2 += (v[j][0] * v[j][0] + v[j][1] * v[j][1]) + (v[j][2] * v[j][2] + v[j][3] * v[j][3]); }
        const float rstd = 1.f / sqrtf(wave_sum(s2) * (1.f / DM) + LN_EPS);
        float* xo = m < MLAT ? a.out + (size_t)m * DM : XC + (size_t)(m - MLAT) * DM;
        const float* md = mod + (size_t)(m < MLAT ? (m >> 12) : 8) * 3072;
#pragma unroll
        for (int j = 0; j < 4; ++j) {
            const int cix = 4 * lane + 256 * j;
            const f32x4 o = v[j] * rstd * *(const f32x4*)(gam + cix) + *(const f32x4*)(bet + cix);
            *(f32x4*)(xo + cix) = o;
            if (l < DEPTH - 1) {
                const f32x4 sh = *(const f32x4*)(md + cix), sc = *(const f32x4*)(md + 1024 + cix);
                const f32x4 hh = o * (sc + 1.f) + sh;
                u32x2 w; w.x = pkbf(hh[0], hh[1]); w.y = pkbf(hh[2], hh[3]);
                *(u32x2*)(H + (size_t)m * DM + cix) = w;
            }
        }
    }
}

__device__ __forceinline__ int crow(int r, int hi) { return (r & 3) + 8 * (r >> 2) + 4 * hi; }
constexpr int AT_KP = 72, AT_VP = 72, AT_OP = 68;
constexpr int AT_KS = 0, AT_VT = 2 * 64 * AT_KP * 2, AT_OS = AT_VT + 2 * 64 * AT_VP * 2;
__device__ __forceinline__ void attn_phase(LAS unsigned char* lds, const bf16_t* __restrict__ P, const float* __restrict__ sink, bf16_t* __restrict__ U, int tid, int bid, int G) {
    const int lane = tid & 63, wid = tid >> 6, q32 = lane & 31, hi = lane >> 5;
    LAS bf16_t* Ks = (LAS bf16_t*)(lds + AT_KS);
    LAS bf16_t* Vt = (LAS bf16_t*)(lds + AT_VT);
    LAS float* Os = (LAS float*)(lds + AT_OS) + wid * 32 * AT_OP;
    const int lkey = tid >> 3, lch = tid & 7;
    for (int u = bid; u < 1088; u += G) {
        bool isctx; int b, kh, qb;
        if (u < 64) { isctx = true; b = u >> 3; kh = (u >> 2) & 1; qb = u & 3; }
        else { const int v = u - 64; isctx = false; b = v >> 7; kh = (v >> 6) & 1; qb = v & 63; }
        const int h = kh * 4 + (wid & 3), rg = wid >> 2;
        const int qrow0 = (isctx ? MLAT + b * CTXL : b * SEQ) + qb * 64 + rg * 32;
        const int qpos = qb * 64 + rg * 32 + q32;
        bf16x8 qf[4];
#pragma unroll
        for (int kk = 0; kk < 4; ++kk) qf[kk] = *(const bf16x8*)(P + (size_t)(qrow0 + q32) * NAB + h * 64 + kk * 16 + hi * 8);
        int jlo = 0, nt = 4;
        if (!isctx) { jlo = qb < 2 ? 2 - qb : 0; const int jhi = (65 - qb) < 4 ? (65 - qb) : 4; nt = 4 + (jhi - jlo + 1); }
        float mrun = sink[h] * LOG2E, lrun = hi == 0 ? 1.f : 0.f;
        f32x16 o0, o1;
#pragma unroll
        for (int r = 0; r < 16; ++r) { o0[r] = 0.f; o1[r] = 0.f; }
        u32x4 kreg, vreg;
#define AT_LOAD(i) do { const int rb_ = (i) < 4 ? MLAT + b * CTXL + 64 * (i) : b * SEQ + 64 * (qb - 2 + jlo + (i) - 4); \
            const bf16_t* src_ = P + (size_t)(rb_ + lkey) * NAB + 512 + kh * 64 + lch * 8; kreg = *(const u32x4*)src_; vreg = *(const u32x4*)(src_ + 128); } while (0)
#define AT_STORE(buf) do { *(LAS u32x4*)(Ks + ((buf) * 64 + lkey) * AT_KP + lch * 8) = kreg; \
            LAS bf16_t* vd_ = Vt + ((buf) * 64 + lch * 8) * AT_VP + lkey; \
            vd_[0 * AT_VP] = (bf16_t)(vreg.x & 0xffffu); vd_[1 * AT_VP] = (bf16_t)(vreg.x >> 16); vd_[2 * AT_VP] = (bf16_t)(vreg.y & 0xffffu); vd_[3 * AT_VP] = (bf16_t)(vreg.y >> 16); \
            vd_[4 * AT_VP] = (bf16_t)(vreg.z & 0xffffu); vd_[5 * AT_VP] = (bf16_t)(vreg.z >> 16); vd_[6 * AT_VP] = (bf16_t)(vreg.w & 0xffffu); vd_[7 * AT_VP] = (bf16_t)(vreg.w >> 16); } while (0)
        AT_LOAD(0); AT_STORE(0);
        __syncthreads();
        for (int i = 0; i < nt; ++i) {
            const int buf = i & 1;
            if (i + 1 < nt) AT_LOAD(i + 1);
            f32x16 s0, s1;
#pragma unroll
            for (int r = 0; r < 16; ++r) { s0[r] = 0.f; s1[r] = 0.f; }
#pragma unroll
            for (int kk = 0; kk < 4; ++kk) {
                const bf16x8 a0 = *(const LAS bf16x8*)(Ks + (buf * 64 + q32) * AT_KP + kk * 16 + hi * 8);
                const bf16x8 a1 = *(const LAS bf16x8*)(Ks + (buf * 64 + 32 + q32) * AT_KP + kk * 16 + hi * 8);
                s0 = __builtin_amdgcn_mfma_f32_32x32x16_bf16(a0, qf[kk], s0, 0, 0, 0);
                s1 = __builtin_amdgcn_mfma_f32_32x32x16_bf16(a1, qf[kk], s1, 0, 0, 0);
            }
            if (i >= 4) {
                const int kp0 = 64 * (qb - 2 + jlo + i - 4) - qpos;
#pragma unroll
                for (int r = 0; r < 16; ++r) { const int d0 = kp0 + crow(r, hi); if (d0 > 128 || d0 < -128) s0[r] = -__builtin_inff(); const int d1 = d0 + 32; if (d1 > 128 || d1 < -128) s1[r] = -__builtin_inff(); }
            }
            float mx = s0[0];
#pragma unroll
            for (int r = 1; r < 16; ++r) mx = fmaxf(mx, s0[r]);
#pragma unroll
            for (int r = 0; r < 16; ++r) mx = fmaxf(mx, s1[r]);
            mx = fmaxf(mx, __shfl_xor(mx, 32));
            const float mnew = fmaxf(mrun, mx), alpha = __builtin_amdgcn_exp2f(mrun - mnew);
            mrun = mnew;
            float ls = 0.f;
#pragma unroll
            for (int r = 0; r < 16; ++r) { s0[r] = __builtin_amdgcn_exp2f(s0[r] - mnew); s1[r] = __builtin_amdgcn_exp2f(s1[r] - mnew); ls += s0[r] + s1[r]; }
            lrun = lrun * alpha + ls;
#pragma unroll
            for (int r = 0; r < 16; ++r) { o0[r] *= alpha; o1[r] *= alpha; }
#pragma unroll
            for (int sub = 0; sub < 2; ++sub)
#pragma unroll
                for (int st = 0; st < 2; ++st) {
                    u32x4 pw;
                    if (sub == 0) { pw.x = pkbf(s0[8 * st + 0], s0[8 * st + 1]); pw.y = pkbf(s0[8 * st + 2], s0[8 * st + 3]); pw.z = pkbf(s0[8 * st + 4], s0[8 * st + 5]); pw.w = pkbf(s0[8 * st + 6], s0[8 * st + 7]); }
                    else          { pw.x = pkbf(s1[8 * st + 0], s1[8 * st + 1]); pw.y = pkbf(s1[8 * st + 2], s1[8 * st + 3]); pw.z = pkbf(s1[8 * st + 4], s1[8 * st + 5]); pw.w = pkbf(s1[8 * st + 6], s1[8 * st + 7]); }
                    const bf16x8 pb = __builtin_bit_cast(bf16x8, pw);
                    const int kc = 32 * sub + 16 * st + 4 * hi;
                    {
                        const LAS bf16_t* vp = Vt + (buf * 64 + q32) * AT_VP + kc;
                        u32x4 aw; const u32x2 lo = *(const LAS u32x2*)vp, hh = *(const LAS u32x2*)(vp + 8); aw.x = lo.x; aw.y = lo.y; aw.z = hh.x; aw.w = hh.y;
                        o0 = __builtin_amdgcn_mfma_f32_32x32x16_bf16(__builtin_bit_cast(bf16x8, aw), pb, o0, 0, 0, 0);
                    }
                    {
                        const LAS bf16_t* vp = Vt + (buf * 64 + 32 + q32) * AT_VP + kc;
                        u32x4 aw; const u32x2 lo = *(const LAS u32x2*)vp, hh = *(const LAS u32x2*)(vp + 8); aw.x = lo.x; aw.y = lo.y; aw.z = hh.x; aw.w = hh.y;
                        o1 = __builtin_amdgcn_mfma_f32_32x32x16_bf16(__builtin_bit_cast(bf16x8, aw), pb, o1, 0, 0, 0);
                    }
                }
            if (i + 1 < nt) AT_STORE(buf ^ 1);
            __syncthreads();
        }
#undef AT_LOAD
#undef AT_STORE
        const float linv = 1.f / (lrun + __shfl_xor(lrun, 32));
#pragma unroll
        for (int r = 0; r < 16; ++r) { Os[q32 * AT_OP + crow(r, hi)] = o0[r] * linv; Os[q32 * AT_OP + 32 + crow(r, hi)] = o1[r] * linv; }
        asm volatile("s_waitcnt lgkmcnt(0)" ::: "memory");
#pragma unroll
        for (int it = 0; it < 4; ++it) {
            const int qq = it * 8 + (lane >> 3), ch = lane & 7;
            const f32x4 x0 = *(const LAS f32x4*)(Os + qq * AT_OP + ch * 8), x1 = *(const LAS f32x4*)(Os + qq * AT_OP + ch * 8 + 4);
            const size_t row = (size_t)(qrow0 + qq);
            const u32x4 gw = *(const u32x4*)(P + row * NAB + 768 + h * 64 + ch * 8);
            u32x4 w;
            w.x = pkbf(x0[0] * silu_f(bflo(gw.x)), x0[1] * silu_f(bfhi(gw.x))); w.y = pkbf(x0[2] * silu_f(bflo(gw.y)), x0[3] * silu_f(bfhi(gw.y)));
            w.z = pkbf(x1[0] * silu_f(bflo(gw.z)), x1[1] * silu_f(bfhi(gw.z))); w.w = pkbf(x1[2] * silu_f(bflo(gw.w)), x1[3] * silu_f(bfhi(gw.w)));
            *(u32x4*)(U + row * DM + h * 64 + ch * 8) = w;
        }
        asm volatile("s_waitcnt lgkmcnt(0)" ::: "memory");
    }
}
__device__ __forceinline__ void conv_phase(const bf16_t* __restrict__ P, const float* __restrict__ cw, bf16_t* __restrict__ U, int tid, int bid, int G) {
    const long total = (long)MTOT * 64;
    for (long idx = (long)bid * NTHR + tid; idx < total; idx += (long)G * NTHR) {
        const int ch = (int)(idx & 63); const int m = (int)(idx >> 6);
        int t, L; if (m < MLAT) { t = m & (SEQ - 1); L = SEQ; } else { t = (m - MLAT) & (CTXL - 1); L = CTXL; }
        const bf16_t* pr = P + (size_t)m * NAB + ch * 8;
        const u32x4 xb1 = *(const u32x4*)(pr + 1280), cg1 = *(const u32x4*)(pr + 2304), bg = *(const u32x4*)(pr + 1792), gb = *(const u32x4*)(pr + 2816);
        u32x4 xb0 = {0u, 0u, 0u, 0u}, cg0 = {0u, 0u, 0u, 0u}, xb2 = {0u, 0u, 0u, 0u}, cg2 = {0u, 0u, 0u, 0u};
        if (t > 0) { xb0 = *(const u32x4*)(pr - NAB + 1280); cg0 = *(const u32x4*)(pr - NAB + 2304); }
        if (t < L - 1) { xb2 = *(const u32x4*)(pr + NAB + 1280); cg2 = *(const u32x4*)(pr + NAB + 2304); }
        const float* w0 = cw + ch * 8; const float* w1 = cw + 512 + ch * 8; const float* w2 = cw + 1024 + ch * 8;
        const f32x4 w0a = *(const f32x4*)w0, w0b = *(const f32x4*)(w0 + 4), w1a = *(const f32x4*)w1, w1b = *(const f32x4*)(w1 + 4), w2a = *(const f32x4*)w2, w2b = *(const f32x4*)(w2 + 4);
        float o[8];
#define CV(j, XB0, CG0, XB1, CG1, XB2, CG2, BG, GB, W0, W1, W2, LOHI) { const float y = W0 * (LOHI(XB0) * LOHI(CG0)) + W1 * (LOHI(XB1) * LOHI(CG1)) + W2 * (LOHI(XB2) * LOHI(CG2)); o[j] = LOHI(BG) * y * silu_f(LOHI(GB)); }
        CV(0, xb0.x, cg0.x, xb1.x, cg1.x, xb2.x, cg2.x, bg.x, gb.x, w0a[0], w1a[0], w2a[0], bflo)
        CV(1, xb0.x, cg0.x, xb1.x, cg1.x, xb2.x, cg2.x, bg.x, gb.x, w0a[1], w1a[1], w2a[1], bfhi)
        CV(2, xb0.y, cg0.y, xb1.y, cg1.y, xb2.y, cg2.y, bg.y, gb.y, w0a[2], w1a[2], w2a[2], bflo)
        CV(3, xb0.y, cg0.y, xb1.y, cg1.y, xb2.y, cg2.y, bg.y, gb.y, w0a[3], w1a[3], w2a[3], bfhi)
        CV(4, xb0.z, cg0.z, xb1.z, cg1.z, xb2.z, cg2.z, bg.z, gb.z, w0b[0], w1b[0], w2b[0], bflo)
        CV(5, xb0.z, cg0.z, xb1.z, cg1.z, xb2.z, cg2.z, bg.z, gb.z, w0b[1], w1b[1], w2b[1], bfhi)
        CV(6, xb0.w, cg0.w, xb1.w, cg1.w, xb2.w, cg2.w, bg.w, gb.w, w0b[2], w1b[2], w2b[2], bflo)
        CV(7, xb0.w, cg0.w, xb1.w, cg1.w, xb2.w, cg2.w, bg.w, gb.w, w0b[3], w1b[3], w2b[3], bfhi)
#undef CV
        u32x4 w; w.x = pkbf(o[0], o[1]); w.y = pkbf(o[2], o[3]); w.z = pkbf(o[4], o[5]); w.w = pkbf(o[6], o[7]);
        *(u32x4*)(U + (size_t)m * DM + 512 + ch * 8) = w;
    }
}
constexpr int SC_QP = 136, SC_TP = 40;
constexpr int SC_QI = 0, SC_QA = SC_QI + 32 * SC_QP * 2, SC_KA = SC_QA + 32 * SC_QP * 2, SC_KST = SC_KA + 32 * SC_QP * 2, SC_VT = SC_KST + 128 * SC_TP * 2,
              SC_PM = SC_VT + 128 * SC_TP * 2, SC_DEC = SC_PM + 32 * SC_TP * 2, SC_BUF = SC_DEC + 512;
__device__ __forceinline__ void scan_phase(LAS unsigned char* lds, bf16_t* P, const float* __restrict__ lbv, int tid, int bid, int G, bool store_o) {
    const int lane = tid & 63, w = tid >> 6, d16 = lane & 15, quad = lane >> 4;
    for (int item = bid; item < 128; item += G) {
        const int dir = item & 1, bh = item >> 1, b = bh >> 3, h = bh & 7;
        const int d = 16 * w + d16;
        const float lb = lbv[dir * 2048 + h * 128 + d], omlb = 1.f - lb;
        const int zcol = (dir ? 2048 : 1024) + h * 128, qcol = h * 128, icol = 3072 + h * 128;
        f32x4 S[8];
#pragma unroll
        for (int i = 0; i < 8; ++i) S[i] = (f32x4){0.f, 0.f, 0.f, 0.f};
        unsigned short zr[8], qr[8]; u32x4 vreg;
        const int vp = tid >> 4, vch = tid & 15;
#define SC_ROWBASE(n) ((n) < 8 ? MLAT + b * CTXL + (dir ? 224 - 32 * (n) : 32 * (n)) : b * SEQ + (dir ? 4064 - 32 * ((n) - 8) : 32 * ((n) - 8)))
#define SC_LOAD(n) do { const int rb_ = SC_ROWBASE(n); \
            _Pragma("unroll") for (int i = 0; i < 8; ++i) { const int c_ = 8 * quad + i; const bf16_t* rp_ = P + (size_t)(rb_ + (dir ? 31 - c_ : c_)) * NCC; zr[i] = rp_[zcol + d]; qr[i] = rp_[qcol + d]; } \
            vreg = *(const u32x4*)(P + (size_t)(rb_ + vp) * NCC + icol + vch * 8); } while (0)
        SC_LOAD(0);
        for (int n = 0; n < 136; ++n) {
            LAS unsigned char* B = lds + (n & 1) * SC_BUF;
            LAS bf16_t* QI = (LAS bf16_t*)(B + SC_QI); LAS bf16_t* QA = (LAS bf16_t*)(B + SC_QA); LAS bf16_t* KA = (LAS bf16_t*)(B + SC_KA);
            LAS bf16_t* KST = (LAS bf16_t*)(B + SC_KST); LAS bf16_t* VT = (LAS bf16_t*)(B + SC_VT); LAS bf16_t* PM = (LAS bf16_t*)(B + SC_PM); LAS float* DEC = (LAS float*)(B + SC_DEC);
            const int rb = SC_ROWBASE(n);
            {
                float lf[8], kk[8];
#pragma unroll
                for (int i = 0; i < 8; ++i) {
                    const float z = h2f(zr[i]); const float e = __expf(-fabsf(z)); const float r1 = 1.f / (1.f + e);
                    const float sg = z >= 0.f ? r1 : e * r1, sgm = z >= 0.f ? e * r1 : r1;
                    lf[i] = __logf(lb + omlb * sg); kk[i] = omlb * sgm;
                }
                float cs[8]; float run = 0.f;
#pragma unroll
                for (int i = 0; i < 8; ++i) { run += lf[i]; cs[i] = run; }
                const float t0 = __shfl(run, d16), t1 = __shfl(run, d16 + 16), t2 = __shfl(run, d16 + 32), t3 = __shfl(run, d16 + 48);
                const float off = (quad > 0 ? t0 : 0.f) + (quad > 1 ? t1 : 0.f) + (quad > 2 ? t2 : 0.f);
                const float blast = (t0 + t1) + (t2 + t3), bref = t0 + t1;
                unsigned ksw[4];
#pragma unroll
                for (int i = 0; i < 8; i += 2) {
                    float ksv[2];
#pragma unroll
                    for (int jj = 0; jj < 2; ++jj) {
                        const int ii = i + jj; const float bi = cs[ii] + off; const float qv = bf2f(qr[ii]); const int c = 8 * quad + ii;
                        QI[c * SC_QP + d] = f2bf1(qv * __expf(bi)); QA[c * SC_QP + d] = f2bf1(qv * __expf(bi - bref)); KA[c * SC_QP + d] = f2bf1(kk[ii] * __expf(bref - bi));
                        ksv[jj] = kk[ii] * __expf(blast - bi);
                    }
                    ksw[i >> 1] = pkbf(ksv[0], ksv[1]);
                }
                *(LAS u32x4*)(KST + d * SC_TP + 8 * quad) = (u32x4){ksw[0], ksw[1], ksw[2], ksw[3]};
                if (quad == 0) DEC[d] = __expf(blast);
                const int cv = dir ? 31 - vp : vp;
                LAS bf16_t* vd = VT + (vch * 8) * SC_TP + cv;
                vd[0 * SC_TP] = (bf16_t)(vreg.x & 0xffffu); vd[1 * SC_TP] = (bf16_t)(vreg.x >> 16); vd[2 * SC_TP] = (bf16_t)(vreg.y & 0xffffu); vd[3 * SC_TP] = (bf16_t)(vreg.y >> 16);
                vd[4 * SC_TP] = (bf16_t)(vreg.z & 0xffffu); vd[5 * SC_TP] = (bf16_t)(vreg.z >> 16); vd[6 * SC_TP] = (bf16_t)(vreg.w & 0xffffu); vd[7 * SC_TP] = (bf16_t)(vreg.w >> 16);
            }
            if (n + 1 < 136) SC_LOAD(n + 1);
            __syncthreads();
            if (w < 4) {
                const int ct = w >> 1, st = w & 1;
                f32x4 sc = {0.f, 0.f, 0.f, 0.f};
                if (st <= ct) {
#pragma unroll
                    for (int k4 = 0; k4 < 4; ++k4) {
                        const bf16x8 av = *(const LAS bf16x8*)(QA + (16 * ct + d16) * SC_QP + 32 * k4 + 8 * quad);
                        const bf16x8 bv = *(const LAS bf16x8*)(KA + (16 * st + d16) * SC_QP + 32 * k4 + 8 * quad);
                        sc = __builtin_amdgcn_mfma_f32_16x16x32_bf16(av, bv, sc, 0, 0, 0);
                    }
                }
#pragma unroll
                for (int r = 0; r < 4; ++r) { const int cc = 16 * ct + 4 * quad + r, ss = 16 * st + d16; PM[cc * SC_TP + ss] = f2bf1(ss <= cc ? sc[r] : 0.f); }
            }
            f32x4 O0 = {0.f, 0.f, 0.f, 0.f}, O1 = {0.f, 0.f, 0.f, 0.f};
#pragma unroll
            for (int k4 = 0; k4 < 4; ++k4) {
                u32x4 bw; bw.x = pkbf(S[2 * k4][0], S[2 * k4][1]); bw.y = pkbf(S[2 * k4][2], S[2 * k4][3]); bw.z = pkbf(S[2 * k4 + 1][0], S[2 * k4 + 1][1]); bw.w = pkbf(S[2 * k4 + 1][2], S[2 * k4 + 1][3]);
                const bf16x8 bv = __builtin_bit_cast(bf16x8, bw);
                {
                    const LAS bf16_t* ap = QI + d16 * SC_QP + 32 * k4 + 4 * quad;
                    u32x4 aw; const u32x2 lo = *(const LAS u32x2*)ap, hh = *(const LAS u32x2*)(ap + 16); aw.x = lo.x; aw.y = lo.y; aw.z = hh.x; aw.w = hh.y;
                    O0 = __builtin_amdgcn_mfma_f32_16x16x32_bf16(__builtin_bit_cast(bf16x8, aw), bv, O0, 0, 0, 0);
                }
                {
                    const LAS bf16_t* ap = QI + (16 + d16) * SC_QP + 32 * k4 + 4 * quad;
                    u32x4 aw; const u32x2 lo = *(const LAS u32x2*)ap, hh = *(const LAS u32x2*)(ap + 16); aw.x = lo.x; aw.y = lo.y; aw.z = hh.x; aw.w = hh.y;
                    O1 = __builtin_amdgcn_mfma_f32_16x16x32_bf16(__builtin_bit_cast(bf16x8, aw), bv, O1, 0, 0, 0);
                }
            }
            __syncthreads();
            const bf16x8 vB = *(const LAS bf16x8*)(VT + (16 * w + d16) * SC_TP + 8 * quad);
            O0 = __builtin_amdgcn_mfma_f32_16x16x32_bf16(*(const LAS bf16x8*)(PM + d16 * SC_TP + 8 * quad), vB, O0, 0, 0, 0);
            O1 = __builtin_amdgcn_mfma_f32_16x16x32_bf16(*(const LAS bf16x8*)(PM + (16 + d16) * SC_TP + 8 * quad), vB, O1, 0, 0, 0);
            if (store_o)
#pragma unroll
            for (int r = 0; r < 4; ++r) {
                const int c0 = 4 * quad + r, c1 = 16 + c0;
                P[(size_t)(rb + (dir ? 31 - c0 : c0)) * NCC + zcol + 16 * w + d16] = f2bf1(O0[r]);
                P[(size_t)(rb + (dir ? 31 - c1 : c1)) * NCC + zcol + 16 * w + d16] = f2bf1(O1[r]);
            }
#pragma unroll
            for (int dt = 0; dt < 8; ++dt) {
                const f32x4 dc = *(const LAS f32x4*)(DEC + 16 * dt + 4 * quad);
                const bf16x8 kA = *(const LAS bf16x8*)(KST + (16 * dt + d16) * SC_TP + 8 * quad);
                S[dt] = __builtin_amdgcn_mfma_f32_16x16x32_bf16(kA, vB, S[dt] * dc, 0, 0, 0);
            }
        }
#undef SC_LOAD
#undef SC_ROWBASE
        __syncthreads();
    }
}
__device__ __forceinline__ void readout_phase(const bf16_t* __restrict__ P, const float* __restrict__ gn, bf16_t* __restrict__ U, int mrows, int tid, int bid, int G) {
    const long total = (long)mrows * 128;
    for (long idx = (long)bid * NTHR + tid; idx < total; idx += (long)G * NTHR) {
        const int ch = (int)(idx & 15), h = (int)((idx >> 4) & 7); const int m = (int)(idx >> 7);
        const bf16_t* pr = P + (size_t)m * NCC + h * 128 + ch * 8;
        const u32x4 of = *(const u32x4*)(pr + 1024), ob = *(const u32x4*)(pr + 2048), gg = *(const u32x4*)(pr + 4096);
        float o[8];
        o[0] = bflo(of.x) + bflo(ob.x); o[1] = bfhi(of.x) + bfhi(ob.x); o[2] = bflo(of.y) + bflo(ob.y); o[3] = bfhi(of.y) + bfhi(ob.y);
        o[4] = bflo(of.z) + bflo(ob.z); o[5] = bfhi(of.z) + bfhi(ob.z); o[6] = bflo(of.w) + bflo(ob.w); o[7] = bfhi(of.w) + bfhi(ob.w);
        float ss = 0.f;
#pragma unroll
        for (int j = 0; j < 8; ++j) ss += o[j] * o[j];
        ss += __shfl_xor(ss, 1); ss += __shfl_xor(ss, 2); ss += __shfl_xor(ss, 4); ss += __shfl_xor(ss, 8);
        const float rs = 1.f / sqrtf(ss * (1.f / 128.f) + RMS_EPS);
        const f32x4 g0 = *(const f32x4*)(gn + ch * 8), g1 = *(const f32x4*)(gn + ch * 8 + 4);
        u32x4 wv;
        wv.x = pkbf(o[0] * rs * g0[0] * silu_f(bflo(gg.x)), o[1] * rs * g0[1] * silu_f(bfhi(gg.x)));
        wv.y = pkbf(o[2] * rs * g0[2] * silu_f(bflo(gg.y)), o[3] * rs * g0[3] * silu_f(bfhi(gg.y)));
        wv.z = pkbf(o[4] * rs * g1[0] * silu_f(bflo(gg.z)), o[5] * rs * g1[1] * silu_f(bfhi(gg.z)));
        wv.w = pkbf(o[6] * rs * g1[2] * silu_f(bflo(gg.w)), o[7] * rs * g1[3] * silu_f(bfhi(gg.w)));
        *(u32x4*)(U + (size_t)m * DM + h * 128 + ch * 8) = wv;
    }
}

__global__ void __launch_bounds__(NTHR, 2) fwd_megakernel(Args a) {
    extern __shared__ __attribute__((aligned(16))) unsigned char lds_raw[];
    LAS unsigned char* lds = (LAS unsigned char*)lds_raw;
    cg::grid_group grid = cg::this_grid();
    const int tid0 = threadIdx.x, bid = blockIdx.x, G = gridDim.x;
#define XSYNC() do {} while (0)
#define GSYNC() xcd_barrier(xbar)
#define FRESH_TID() int tid = tid0; asm volatile("" : "+v"(tid))
    if (tid0 < 4) ((volatile LAS unsigned*)(lds + 131072 + 256))[tid0] = 0u;
    __syncthreads();
    const XcdBarrier xbar = xcd_barrier_post((unsigned*)a.ws, (volatile LAS unsigned*)(lds + 131072 + 256));
    bf16_t* HU = (bf16_t*)(a.ws + WS_HU);
    bf16_t* PROJ = (bf16_t*)(a.ws + WS_PROJ);
    float* VPRE = (float*)(a.ws + WS_PROJ);
    const float* mod = (const float*)(a.ws + WS_MOD);
    { FRESH_TID(); prologue_a(a, lds, tid, bid, G); }
    grid.sync(); XSYNC();
    { FRESH_TID(); prologue_b(a, tid, bid, G); }
    GSYNC(); XSYNC();
#pragma nounroll
    for (int l = 0; l < DEPTH; ++l) {
        const int j = l >> 1;
        const int mrows = (l == DEPTH - 1) ? MLAT : MTOT;
        if ((l & 1) == 0) {
            { pg8::Gemm g{HU, (const bf16_t*)(a.ws + WS_WINAB) + (size_t)j * NAB * DM, MTOT, NAB, DM}; pg8::StaticOrder S; S.init(MTOT, NAB, G, bid);
              EpiAB E{PROJ, (const float*)(a.ws + WS_ROPE)};
              pg8::gemm_phase<EpiAB, pg8::StaticOrder, PG8_ALIGN, PG8_SP2>(lds, g, S, E); }
            GSYNC(); XSYNC();
            { FRESH_TID(); attn_phase(lds, PROJ, a.sink_ab + j * 8, HU, tid, bid, G); }
#ifdef PROBE_ATTN2
            { FRESH_TID(); attn_phase(lds, PROJ, a.sink_ab + j * 8, HU, tid, bid, G); }
#endif
            { FRESH_TID(); conv_phase(PROJ, a.conv_ab + j * 3 * 512, HU, tid, bid, G); }
            GSYNC(); XSYNC();
        } else {
            { pg8::Gemm g{HU, (const bf16_t*)(a.ws + WS_WINC) + (size_t)j * NCC * DM, MTOT, NCC, DM}; pg8::StaticOrder S; S.init(MTOT, NCC, G, bid);
              EpiC E{PROJ};
              pg8::gemm_phase<EpiC, pg8::StaticOrder, PG8_ALIGN, PG8_SP2>(lds, g, S, E); }
            GSYNC(); XSYNC();
            { FRESH_TID(); scan_phase(lds, PROJ, (const float*)(a.ws + WS_LB) + j * 1024, tid, bid, G, a.out != nullptr); }
#ifdef PROBE_SCAN2
            { FRESH_TID(); scan_phase(lds, PROJ, (const float*)(a.ws + WS_LB) + j * 1024, tid, bid, G, a.out == nullptr); }
#endif
            GSYNC(); XSYNC();
            { FRESH_TID(); readout_phase(PROJ, a.gnorm_c + j * 128, HU, mrows, tid, bid, G); }
            GSYNC(); XSYNC();
        }
        { const bf16_t* wo = (l & 1) ? (const bf16_t*)(a.ws + WS_WOUTC) + (size_t)j * DM * DM : (const bf16_t*)(a.ws + WS_WOUTAB) + (size_t)j * DM * DM;
          pg8::Gemm g{HU, wo, mrows, DM, DM}; pg8::StaticOrder S; S.init(mrows, DM, G, bid);
          EpiOut E{l == 0 ? a.x : a.out, l == 0 ? a.ctx : (const float*)(a.ws + WS_XC), mod + (size_t)l * 9 * 3072 + 2048, VPRE};
          pg8::gemm_phase<EpiOut, pg8::StaticOrder, PG8_ALIGN, PG8_SP2>(lds, g, S, E); }
        GSYNC(); XSYNC();
        { FRESH_TID(); ln_phase(a, l, mrows, tid, bid, G); }
        if (l < DEPTH - 1) { GSYNC(); XSYNC(); }
    }
}

extern "C" void kernel_launch(void* const* d_in, const int* in_sizes, int n_in, void* d_out, int out_size, void* d_ws, size_t ws_size, hipStream_t stream) {
    static int grid_blocks = 0;
    if (grid_blocks == 0) {
        if (n_in != 16 || ws_size < WS_END) { fprintf(stderr, "kernel_launch: unexpected n_in %d / ws_size %zu\n", n_in, ws_size); grid_blocks = -1; return; }
        int dev = 0, cus = 0, per_cu = 0;
        hipGetDevice(&dev);
        hipDeviceGetAttribute(&cus, hipDeviceAttributeMultiprocessorCount, dev);
        if (hipFuncSetAttribute((const void*)fwd_megakernel, hipFuncAttributeMaxDynamicSharedMemorySize, LDS_BYTES) != hipSuccess) { fprintf(stderr, "kernel_launch: hipFuncSetAttribute failed\n"); grid_blocks = -1; return; }
        if (hipOccupancyMaxActiveBlocksPerMultiprocessor(&per_cu, (const void*)fwd_megakernel, NTHR, LDS_BYTES) != hipSuccess || per_cu < 1) { fprintf(stderr, "kernel_launch: occupancy query gave %d\n", per_cu); per_cu = 1; }
        (void)hipGetLastError();
        grid_blocks = cus * per_cu;
        fprintf(stderr, "kernel_launch: cus %d per_cu %d grid %d ws %zu\n", cus, per_cu, grid_blocks, ws_size);
    }
    if (grid_blocks < 0) return;
    Args a{};
    a.x = (const float*)d_in[0]; a.c = (const float*)d_in[1]; a.ctx = (const float*)d_in[2]; a.c_ctx = (const float*)d_in[3]; a.w_ada = (const float*)d_in[4]; a.b_ada = (const float*)d_in[5];
    a.ln_g = (const float*)d_in[6]; a.ln_b = (const float*)d_in[7]; a.w_in_ab = (const float*)d_in[8]; a.w_out_ab = (const float*)d_in[9]; a.sink_ab = (const float*)d_in[10]; a.conv_ab = (const float*)d_in[11];
    a.w_in_c = (const float*)d_in[12]; a.w_out_c = (const float*)d_in[13]; a.lb_c = (const float*)d_in[14]; a.gnorm_c = (const float*)d_in[15];
    a.out = (float*)d_out; a.ws = (unsigned char*)d_ws;
    if (hipMemsetAsync(d_ws, 0, 16384, stream) != hipSuccess) { fprintf(stderr, "kernel_launch: memset failed\n"); return; }
    void* args[] = {&a};
    hipError_t e = hipLaunchCooperativeKernel((const void*)fwd_megakernel, dim3(grid_blocks), dim3(NTHR), args, LDS_BYTES, stream);
    if (e != hipSuccess) fprintf(stderr, "kernel_launch: cooperative launch failed: %s (grid %d)\n", hipGetErrorString(e), grid_blocks);
}
```

```cpp
#include <hip/hip_runtime.h>
#include <hip/hip_cooperative_groups.h>
#include <cstdio>
#include <cstdint>
namespace cg = cooperative_groups;
namespace pg8 {
#define PG8_LAS __attribute__((address_space(3)))
typedef unsigned short bf16_t;
typedef short bf16x8 __attribute__((ext_vector_type(8)));
typedef float f32x4 __attribute__((ext_vector_type(4)));
typedef unsigned u32x4 __attribute__((ext_vector_type(4)));
constexpr int BM = 256, BK = 64, HALF = 128, HTB = HALF * BK * 2  , STAGE_BYTES = 8 * HTB, NXCD = 8, WGM = 8;

__host__ __device__ __forceinline__ int lds_byte(int r, int c) { const int st = (r >> 4) * 2 + (c >> 5), rr = r & 15, cc = c & 31, ob = rr * 64 + cc * 2; return st * 1024 + (ob ^ (((ob >> 9) & 1) << 5)); }
__host__ __device__ __forceinline__ void stage_rc(int b, int& R, int& C) { const int st = b / 1024, sb = b % 1024, swz = sb ^ (((sb >> 9) & 1) << 5); R = (st >> 1) * 16 + swz / 64; C = (st & 1) * 32 + (swz % 64) / 2; }
__host__ __device__ __forceinline__ int perm32(int rho) { const int n = rho >> 4, i = rho & 15; return 8 * (i >> 2) + 4 * n + (i & 3); }

struct Unit { int pm, pn; };
struct Gemm { const bf16_t* A; const bf16_t* Bt; int M, N, K; int wave; };
__device__ __forceinline__ int fresh_lane() { int l; asm volatile("v_mbcnt_lo_u32_b32 %0, -1, 0\n\tv_mbcnt_hi_u32_b32 %0, -1, %0" : "=v"(l)); return l; }

struct StaticOrder {
    int nM, nN, nwg, G, c;
    __host__ __device__ void init(int M, int N, int G_, int c_) { nM = M / BM; nN = N / BM; nwg = nM * nN; G = G_; c = c_; }
    __host__ __device__ bool next(int i, Unit& u) const {
        const long L = (long)i * G + c; if (L >= nwg) return false;
        int wgid = (int)L; { const int q = nwg / NXCD, r = nwg % NXCD, xcd = wgid % NXCD, off = wgid / NXCD; wgid = (xcd < r ? xcd * (q + 1) : r * (q + 1) + (xcd - r) * q) + off; }
        const int nig = WGM * nN, gid = wgid / nig, fm = gid * WGM, gsz = (nM - fm) < WGM ? (nM - fm) : WGM;
        u.pm = fm + ((wgid % nig) % gsz); u.pn = (wgid % nig) / gsz; return true;
    }
    __device__ __forceinline__ void a_ready(const Unit&) const {}
    __device__ __forceinline__ void done(const Unit&) const {}
};

template <class Epi, class Sched, bool ALIGN_EPI = false, bool SP2 = false>
__device__ __forceinline__ void gemm_phase(PG8_LAS unsigned char* lds, const Gemm g, const Sched& S, const Epi& E) {
    int tid_l = g.wave * 64 + fresh_lane();
    const int tid = tid_l, wid = __builtin_amdgcn_readfirstlane(tid >> 6), lane = tid & 63, wr = wid >> 2, wc = wid & 3, fr = lane & 15, fq = lane >> 4;
    const int K = g.K, nt = K / BK;
    unsigned voffA[2], voffB[2];
#pragma unroll
    for (int i = 0; i < 2; ++i) { int R, C; stage_rc(tid * 16 + i * 8192, R, C); const int Rb = Epi::PERM ? ((R & ~31) + perm32(R & 31)) : R;
        voffA[i] = (unsigned)(R * K + C) * 2u; voffB[i] = (unsigned)(Rb * K + C) * 2u; }
    const size_t kstep = (size_t)(BK * 2);
    const size_t hstep = (size_t)HALF * K * 2;
    const size_t tstep = 2 * hstep;
    const unsigned ldsw = (unsigned)wid * 1024u;
    const int aoff = lds_byte(wr * 64 + fr, fq * 8), boff = lds_byte(wc * 32 + fr, fq * 8);
#define PG8_SA(b, h) (((b) * 2 + (h)) * HTB)
#define PG8_SB(b, h) ((4 + (b) * 2 + (h)) * HTB)
#define PG8_STAGE(bufoff, gbase, voff) do { _Pragma("unroll") for (int _i = 0; _i < 2; ++_i) \
        __builtin_amdgcn_global_load_lds((const unsigned*)((const char*)(gbase) + (voff)[_i]), (PG8_LAS unsigned*)(lds + (bufoff) + ldsw + _i * 8192), 16, 0, 0); } while (0)
#define PG8_LDA(dst, b, h) do { _Pragma("unroll") for (int m = 0; m < 4; ++m) _Pragma("unroll") for (int k = 0; k < 2; ++k) dst[m][k] = *(const PG8_LAS bf16x8*)(lds + PG8_SA(b, h) + aoff + m * 2048 + k * 1024); } while (0)
#define PG8_LDB(dst, b, h) do { _Pragma("unroll") for (int n = 0; n < 2; ++n) _Pragma("unroll") for (int k = 0; k < 2; ++k) dst[n][k] = *(const PG8_LAS bf16x8*)(lds + PG8_SB(b, h) + boff + n * 2048 + k * 1024); } while (0)
#define PG8_MMA(ai, bj, At, Bt) do { __builtin_amdgcn_s_setprio(1); _Pragma("unroll") for (int m = 0; m < 4; ++m) _Pragma("unroll") for (int n = 0; n < 2; ++n) _Pragma("unroll") for (int k = 0; k < 2; ++k) \
        acc[ai][bj][m][n] = __builtin_amdgcn_mfma_f32_16x16x32_bf16(Bt[n][k], At[m][k], acc[ai][bj][m][n], 0, 0, 0); __builtin_amdgcn_s_setprio(0); } while (0)
#define PG8_WAIT_V(n) asm volatile("s_waitcnt vmcnt(" #n ")" ::: "memory")
#define PG8_WAIT_L(n) asm volatile("s_waitcnt lgkmcnt(" #n ")" ::: "memory")
#define PG8_BAR __builtin_amdgcn_s_barrier()
#define PG8_SCHED __builtin_amdgcn_sched_barrier(0)
    Unit cur, nxt; int ui = 0;
    if (!S.next(0, cur)) return;
    f32x4 acc[2][2][4][2];
#pragma unroll
    for (int a = 0; a < 2; ++a)
#pragma unroll
        for (int b = 0; b < 2; ++b)
#pragma unroll
            for (int m = 0; m < 4; ++m)
#pragma unroll
                for (int n = 0; n < 2; ++n) acc[a][b][m][n] = (f32x4){0.f, 0.f, 0.f, 0.f};
    bf16x8 At[4][2], B0[2][2], B1[2][2];
    const char* cA = (const char*)g.A + (size_t)cur.pm * tstep; const char* cB = (const char*)g.Bt + (size_t)cur.pn * tstep;
    S.a_ready(cur);
    if constexpr (SP2) {
        PG8_STAGE(PG8_SB(0, 0), cB, voffB); PG8_STAGE(PG8_SB(0, 1), cB + hstep, voffB); PG8_STAGE(PG8_SA(0, 0), cA, voffA); PG8_STAGE(PG8_SA(0, 1), cA + hstep, voffA);
        if (wr == 1) PG8_BAR;
        PG8_WAIT_V(2); PG8_BAR;
        PG8_STAGE(PG8_SB(1, 0), cB + kstep, voffB); PG8_STAGE(PG8_SA(1, 0), cA + kstep, voffA); PG8_STAGE(PG8_SB(1, 1), cB + hstep + kstep, voffB);
        PG8_WAIT_V(6); PG8_BAR;
    } else {
        PG8_STAGE(PG8_SB(0, 0), cB, voffB); PG8_STAGE(PG8_SA(0, 0), cA, voffA); PG8_STAGE(PG8_SB(0, 1), cB + hstep, voffB); PG8_STAGE(PG8_SA(0, 1), cA + hstep, voffA);
        if (wr == 1) PG8_BAR;
        PG8_WAIT_V(4); PG8_BAR;
        PG8_STAGE(PG8_SB(1, 0), cB + kstep, voffB); PG8_STAGE(PG8_SA(1, 0), cA + kstep, voffA); PG8_STAGE(PG8_SB(1, 1), cB + hstep + kstep, voffB);
        PG8_WAIT_V(6); PG8_BAR;
    }
    for (;;) {
        const bool has_next = S.next(ui + 1, nxt);
        const char* nA = has_next ? (const char*)g.A + (size_t)nxt.pm * tstep : cA; const char* nB = has_next ? (const char*)g.Bt + (size_t)nxt.pn * tstep : cB;
        for (int t = 0; t < nt; t += 2) {
            const bool last = (t == nt - 2);
            const char* a1 = cA + (size_t)(t + 1) * kstep;
            const char* a2 = last ? nA : cA + (size_t)(t + 2) * kstep; const char* b2 = last ? nB : cB + (size_t)(t + 2) * kstep;
            const char* a3 = a2 + kstep; const char* b3 = b2 + kstep;
            if (last && has_next) S.a_ready(nxt);
            if constexpr (SP2) {
            PG8_LDB(B0, 0, 0); PG8_LDB(B1, 0, 1); PG8_SCHED; PG8_LDA(At, 0, 0); PG8_STAGE(PG8_SA(1, 1), a1 + hstep, voffA);
            PG8_WAIT_V(8); PG8_WAIT_L(0); PG8_BAR; PG8_MMA(0, 0, At, B0); PG8_MMA(0, 1, At, B1); PG8_BAR; PG8_SCHED;
            PG8_LDA(At, 0, 1); PG8_STAGE(PG8_SB(0, 0), b2, voffB); PG8_STAGE(PG8_SB(0, 1), b2 + hstep, voffB); PG8_STAGE(PG8_SA(0, 0), a2, voffA);
            PG8_WAIT_V(8); PG8_WAIT_L(0); PG8_BAR; PG8_MMA(1, 0, At, B0); PG8_MMA(1, 1, At, B1); PG8_BAR; PG8_SCHED;
            PG8_LDB(B0, 1, 0); PG8_LDB(B1, 1, 1); PG8_SCHED; PG8_LDA(At, 1, 0); PG8_STAGE(PG8_SA(0, 1), a2 + hstep, voffA);
            PG8_WAIT_V(8); PG8_WAIT_L(0); PG8_BAR; PG8_MMA(0, 0, At, B0); PG8_MMA(0, 1, At, B1); PG8_BAR; PG8_SCHED;
            PG8_LDA(At, 1, 1); PG8_STAGE(PG8_SB(1, 0), b3, voffB); PG8_STAGE(PG8_SB(1, 1), b3 + hstep, voffB); PG8_STAGE(PG8_SA(1, 0), a3, voffA);
            PG8_WAIT_V(8); PG8_WAIT_L(0); PG8_BAR; PG8_MMA(1, 0, At, B0); PG8_MMA(1, 1, At, B1); PG8_BAR; PG8_SCHED;
            } else {
            PG8_LDB(B0, 0, 0); PG8_SCHED; PG8_LDA(At, 0, 0); PG8_STAGE(PG8_SA(1, 1), a1 + hstep, voffA);
            PG8_WAIT_L(8); PG8_BAR; PG8_WAIT_L(0); PG8_MMA(0, 0, At, B0); PG8_BAR; PG8_SCHED;
            PG8_LDB(B1, 0, 1); PG8_STAGE(PG8_SB(0, 0), b2, voffB);
            PG8_BAR; PG8_WAIT_L(0); PG8_MMA(0, 1, At, B1); PG8_BAR;
            PG8_LDA(At, 0, 1); PG8_STAGE(PG8_SA(0, 0), a2, voffA);
            PG8_BAR; PG8_WAIT_L(0); PG8_MMA(1, 0, At, B0); PG8_BAR; PG8_SCHED;
            PG8_STAGE(PG8_SB(0, 1), b2 + hstep, voffB);
            PG8_WAIT_V(6); PG8_BAR; PG8_MMA(1, 1, At, B1); PG8_BAR;
            PG8_LDB(B0, 1, 0); PG8_SCHED; PG8_LDA(At, 1, 0); PG8_STAGE(PG8_SA(0, 1), a2 + hstep, voffA);
            PG8_WAIT_L(8); PG8_BAR; PG8_WAIT_L(0); PG8_MMA(0, 0, At, B0); PG8_BAR; PG8_SCHED;
            PG8_LDB(B1, 1, 1); PG8_STAGE(PG8_SB(1, 0), b3, voffB);
            PG8_BAR; PG8_WAIT_L(0); PG8_MMA(0, 1, At, B1); PG8_BAR;
            PG8_LDA(At, 1, 1); PG8_STAGE(PG8_SA(1, 0), a3, voffA);
            PG8_BAR; PG8_WAIT_L(0); PG8_MMA(1, 0, At, B0); PG8_BAR; PG8_SCHED;
            PG8_STAGE(PG8_SB(1, 1), b3 + hstep, voffB);
            PG8_WAIT_V(6); PG8_BAR; PG8_MMA(1, 1, At, B1); PG8_BAR;
            }
        }
        if constexpr (ALIGN_EPI) { if (wr == 0) PG8_BAR; }
        if constexpr (!Epi::AFTER_DRAIN) { E(acc, cur, wr, wc, fr, fq); S.done(cur); }
        if (!has_next) break;
#pragma unroll
        for (int a = 0; a < 2; ++a)
#pragma unroll
            for (int b = 0; b < 2; ++b)
#pragma unroll
                for (int m = 0; m < 4; ++m)
#pragma unroll
                    for (int n = 0; n < 2; ++n) acc[a][b][m][n] = (f32x4){0.f, 0.f, 0.f, 0.f};
        cur = nxt; cA = nA; cB = nB; ++ui;
        if constexpr (ALIGN_EPI) { if (wr == 1) PG8_BAR; }
    }
    PG8_WAIT_V(0);
    if constexpr (!ALIGN_EPI) { if (wr == 0) PG8_BAR; }
    PG8_BAR;
    if constexpr (Epi::AFTER_DRAIN) { E.fused(acc, cur, wr, wc, fr, fq, lds, wid, lane); S.done(cur); }
#undef PG8_SA
#undef PG8_SB
#undef PG8_STAGE
#undef PG8_LDA
#undef PG8_LDB
#undef PG8_MMA
#undef PG8_WAIT_V
#undef PG8_WAIT_L
#undef PG8_BAR
#undef PG8_SCHED
}
}

#ifndef PG8_SP2
#define PG8_SP2 true
#endif
#ifndef PG8_ALIGN
#define PG8_ALIGN true
#endif

constexpr int DM = 1024, NB = 8, SEQ = 4096, CTXL = 256, DEPTH = 4;
constexpr int MLAT = NB * SEQ, MCTX = NB * CTXL, MTOT = MLAT + MCTX;
constexpr int NAB = 3328, NCC = 5120;
constexpr float LN_EPS = 1e-5f, RMS_EPS = 1e-6f;
constexpr float DN_ALPHA = 1.681792830507429f;
constexpr float QSCALE = 0.125f * 1.4426950408889634f;
constexpr float LOG2E = 1.4426950408889634f;
constexpr int NWAVES = 8, NTHR = 512;

constexpr size_t MiB = 1u << 20;
constexpr size_t WS_WINAB = 1 * MiB, WS_WOUTAB = 14 * MiB, WS_WINC = 18 * MiB, WS_WOUTC = 38 * MiB;
constexpr size_t WS_MOD = 42 * MiB, WS_LB = 42 * MiB + 512 * 1024, WS_ROPE = 42 * MiB + 640 * 1024;
constexpr size_t WS_XC = 44 * MiB;
constexpr size_t WS_HU = 52 * MiB;
constexpr size_t WS_PROJ = 120 * MiB;
constexpr size_t WS_END = 460 * MiB;
constexpr int LDS_BYTES = 147456;

#define LAS __attribute__((address_space(3)))
typedef unsigned short bf16_t;
typedef short bf16x8 __attribute__((ext_vector_type(8)));
typedef float f32x4 __attribute__((ext_vector_type(4)));
typedef float f32x16 __attribute__((ext_vector_type(16)));
typedef unsigned u32x4 __attribute__((ext_vector_type(4)));
typedef unsigned u32x2 __attribute__((ext_vector_type(2)));
typedef float f32x2_t __attribute__((ext_vector_type(2)));
typedef __bf16 bf16x2_t __attribute__((ext_vector_type(2)));
typedef _Float16 f16x2_t __attribute__((ext_vector_type(2)));

__device__ __forceinline__ unsigned pkbf(float lo, float hi) { f32x2_t v = {lo, hi}; bf16x2_t b = __builtin_convertvector(v, bf16x2_t); return __builtin_bit_cast(unsigned, b); }
__device__ __forceinline__ unsigned pkh(float lo, float hi) { f32x2_t v = {lo, hi}; f16x2_t b = __builtin_convertvector(v, f16x2_t); return __builtin_bit_cast(unsigned, b); }
__device__ __forceinline__ unsigned short f2bf1(float f) { return (unsigned short)(pkbf(f, 0.f) & 0xffffu); }
__device__ __forceinline__ float bf2f(unsigned short u) { return __uint_as_float((unsigned)u << 16); }
__device__ __forceinline__ float bflo(unsigned u) { return __uint_as_float(u << 16); }
__device__ __forceinline__ float bfhi(unsigned u) { return __uint_as_float(u & 0xffff0000u); }
__device__ __forceinline__ float h2f(unsigned short u) { return (float)__builtin_bit_cast(_Float16, u); }
__device__ __forceinline__ float silu_f(float x) { return x / (1.f + __expf(-x)); }
__device__ __forceinline__ float shflx(float v, int lane, int mask) { return __int_as_float(__builtin_amdgcn_ds_bpermute((lane ^ mask) << 2, __float_as_int(v))); }
__device__ __forceinline__ float wave_sum(float v, int lane) {
#pragma unroll
    for (int o = 1; o < 64; o <<= 1) v += shflx(v, lane, o);
    return v;
}

#define XB_TMO      128
#define XB_XCNT(j)  (256  + 64 * (j))
#define XB_XSUB(j)  (1280 + 64 * (j))
#define XB_XGEN(j)  (2304 + 64 * (j))
#define XB_TOP      3328
#define XB_TOPGEN   3392
#define XCD_BAR_WORDS 3456
#define XB_SPIN_CAP (1u << 18)

__device__ __forceinline__ unsigned xb_ld(unsigned* p)              { return __hip_atomic_load(p, __ATOMIC_RELAXED, __HIP_MEMORY_SCOPE_AGENT); }
__device__ __forceinline__ unsigned xb_add(unsigned* p, unsigned v) { return __hip_atomic_fetch_add(p, v, __ATOMIC_RELAXED, __HIP_MEMORY_SCOPE_AGENT); }
__device__ __forceinline__ unsigned xb_xcc_id() { return (unsigned)__builtin_amdgcn_s_getreg((3 << 11) | 20) & 0xFu; }
#define XB_SPIN(cond, bar) do { unsigned _sp = 0; while (cond) { __builtin_amdgcn_s_sleep(1); \
    if ((++_sp & 255u) == 0u) { if (xb_ld(&(bar)[XB_TMO])) break; if (_sp > XB_SPIN_CAP) { atomicAdd(&(bar)[XB_TMO], 1u); break; } } } } while (0)

struct XcdBarrier {
    unsigned* bar; unsigned x;
    volatile LAS unsigned* st;
};

__device__ __forceinline__ XcdBarrier xcd_barrier_post(unsigned* bar, volatile LAS unsigned* st) {
    XcdBarrier b; b.bar = bar; b.x = xb_xcc_id(); b.st = st;
    if (threadIdx.x == 0) (void)xb_add(&bar[XB_XCNT(b.x)], 1u);
    return b;
}
__device__ __forceinline__ void xcd_barrier_complete(unsigned* bar, unsigned x, unsigned& nloc, unsigned& nx) {
    const unsigned G = gridDim.x * gridDim.y * gridDim.z;
    unsigned sum, cnt, mine, sp = 0u;
    for (;;) {
        sum = 0u; cnt = 0u; mine = 0u;
#pragma unroll
        for (unsigned j = 0; j < 16; ++j) { const unsigned c = xb_ld(&bar[XB_XCNT(j)]); sum += c; cnt += (c > 0u) ? 1u : 0u; mine = (j == x) ? c : mine; }
        if (sum == G) break;
        __builtin_amdgcn_s_sleep(1);
        if ((++sp & 255u) == 0u) { if (xb_ld(&bar[XB_TMO])) break; if (sp > XB_SPIN_CAP) { atomicAdd(&bar[XB_TMO], 1u); break; } }
    }
    nloc = mine > 0u ? mine : 1u; nx = cnt > 0u ? cnt : 1u;
}

__device__ __forceinline__ void xcd_barrier(const XcdBarrier& b, int wave_s) {
    asm volatile("s_waitcnt vmcnt(0)" ::: "memory");
    __syncthreads();
    if (wave_s == 0 && pg8::fresh_lane() == 0) {
        unsigned* bar = b.bar;
        const unsigned bx_ = (unsigned)__builtin_amdgcn_readfirstlane((int)xb_xcc_id());
        __builtin_amdgcn_s_waitcnt(0);
        unsigned nloc = b.st[0], nx = b.st[1];
        if (nloc == 0u) { xcd_barrier_complete(bar, bx_, nloc, nx); b.st[0] = nloc; b.st[1] = nx; }
        const unsigned old = xb_add(&bar[XB_XSUB(bx_)], 1u);
        const unsigned gen = old / nloc;
        if (old + 1u == (gen + 1u) * nloc) {
            __builtin_amdgcn_fence(__ATOMIC_RELEASE, "agent");
            asm volatile("s_waitcnt vmcnt(0)" ::: "memory");
            const unsigned og = xb_add(&bar[XB_TOP], 1u);
            const unsigned tg = og / nx;
            if (og + 1u == (tg + 1u) * nx) xb_add(&bar[XB_TOPGEN], 1u);
            else XB_SPIN(xb_ld(&bar[XB_TOPGEN]) == tg, bar);
            __builtin_amdgcn_fence(__ATOMIC_ACQUIRE, "agent");
            xb_add(&bar[XB_XGEN(bx_)], 1u);
            asm volatile("s_waitcnt vmcnt(0)" ::: "memory");
        } else {
            XB_SPIN(xb_ld(&bar[XB_XGEN(bx_)]) == gen, bar);
            __builtin_amdgcn_fence(__ATOMIC_ACQUIRE, "agent");
            asm volatile("s_waitcnt vmcnt(0)" ::: "memory");
        }
    }
    __syncthreads();
}

struct EpiAB {
    static constexpr bool PERM = false, AFTER_DRAIN = false;
    bf16_t* P; const float* rope;
    __device__ __forceinline__ void operator()(const pg8::f32x4 (&acc)[2][2][4][2], const pg8::Unit& u, int wr_, int wc_, int fr_, int fq_) const {
        const int t_ = pg8::fresh_lane();
        const int wr = wr_, wc = wc_, fr = t_ & 15, fq = (t_ >> 4) & 3;
        const int row0 = u.pm * 256 + wr * 64 + fr;
        const int col0 = u.pn * 256 + wc * 32 + 4 * fq;
        const bool latent = u.pm < (MLAT / 256);
        const bool any_rope = latent && (u.pn <= 2);
#pragma unroll
        for (int ai = 0; ai < 2; ++ai)
#pragma unroll
            for (int m = 0; m < 4; ++m) {
                const int row = row0 + ai * 128 + m * 16;
                f32x4 cs0 = {1.f, 0.f, 1.f, 0.f}, cs1 = {1.f, 0.f, 1.f, 0.f};
                if (any_rope) {
                    const int t = row & (SEQ - 1); const int pos = (wc & 1) ? (t & 63) : (t >> 6);
                    const float* rp = rope + (pos * 16 + 4 * fq) * 2;
                    cs0 = *(const f32x4*)rp; cs1 = *(const f32x4*)(rp + 4);
                }
                bf16_t* rowp = P + (size_t)row * NAB + col0;
#pragma unroll
                for (int bj = 0; bj < 2; ++bj) {
                    const int colbase = u.pn * 256 + bj * 128;
                    f32x4 a = acc[ai][bj][m][0], b = acc[ai][bj][m][1];
                    if (latent && colbase < 640) {
                        f32x4 o1, o2;
                        o1[0] = a[0] * cs0[0] - b[0] * cs0[1]; o2[0] = a[0] * cs0[1] + b[0] * cs0[0];
                        o1[1] = a[1] * cs0[2] - b[1] * cs0[3]; o2[1] = a[1] * cs0[3] + b[1] * cs0[2];
                        o1[2] = a[2] * cs1[0] - b[2] * cs1[1]; o2[2] = a[2] * cs1[1] + b[2] * cs1[0];
                        o1[3] = a[3] * cs1[2] - b[3] * cs1[3]; o2[3] = a[3] * cs1[3] + b[3] * cs1[2];
                        a = o1; b = o2;
                    }
                    if (colbase < 512) { a = a * QSCALE; b = b * QSCALE; }
                    u32x2 w0, w1; w0.x = pkbf(a[0], a[1]); w0.y = pkbf(a[2], a[3]); w1.x = pkbf(b[0], b[1]); w1.y = pkbf(b[2], b[3]);
                    *(u32x2*)(rowp + bj * 128) = w0; *(u32x2*)(rowp + bj * 128 + 16) = w1;
                }
                asm volatile("" ::: "memory");
            }
    }
};
struct EpiC {
    static constexpr bool PERM = false, AFTER_DRAIN = false;
    bf16_t* P; const float* lbv;
    __device__ __forceinline__ void operator()(const pg8::f32x4 (&acc)[2][2][4][2], const pg8::Unit& u, int wr_, int wc_, int fr_, int fq_) const {
        const int t_ = pg8::fresh_lane();
        const int wr = wr_, wc = wc_, fr = t_ & 15, fq = (t_ >> 4) & 3;
        const int row0 = u.pm * 256 + wr * 64 + fr;
        const int col0 = u.pn * 256 + wc * 32 + 4 * fq;
        const int type = u.pn >> 2;
#pragma unroll
        for (int ai = 0; ai < 2; ++ai)
#pragma unroll
            for (int m = 0; m < 4; ++m) {
                bf16_t* rowp = P + (size_t)(row0 + ai * 128 + m * 16) * NCC + col0;
#pragma unroll
                for (int bj = 0; bj < 2; ++bj)
#pragma unroll
                    for (int n = 0; n < 2; ++n) {
                        f32x4 v = acc[ai][bj][m][n]; u32x2 w;
                        if (type == 0) {
#pragma unroll
                            for (int j = 0; j < 4; ++j) v[j] = silu_f(v[j]) * 0.08838834764831845f;
                            w.x = pkbf(v[0], v[1]); w.y = pkbf(v[2], v[3]);
                        } else if (type == 1 || type == 2) {
                            const f32x4 lb4 = *(const f32x4*)(lbv + (type - 1) * 2048 + (col0 - type * 1024) + bj * 128 + n * 16);
#pragma unroll
                            for (int j = 0; j < 4; ++j) v[j] = (1.f - lb4[j]) / (1.f + __expf(v[j]));
                            w.x = pkh(v[0], v[1]); w.y = pkh(v[2], v[3]); }
                        else { w.x = pkbf(v[0], v[1]); w.y = pkbf(v[2], v[3]); }
                        *(u32x2*)(rowp + bj * 128 + n * 16) = w;
                    }
            }
    }
};
struct EpiOut {
    static constexpr bool PERM = false, AFTER_DRAIN = false;
    const float* xlat; const float* xctx; const float* gate; float* V;
    __device__ __forceinline__ void operator()(const pg8::f32x4 (&acc)[2][2][4][2], const pg8::Unit& u, int wr_, int wc_, int fr_, int fq_) const {
        const int t_ = pg8::fresh_lane();
        const int wr = wr_, wc = wc_, fr = t_ & 15, fq = (t_ >> 4) & 3;
        const int row0 = u.pm * 256 + wr * 64 + fr;
        const int col0 = u.pn * 256 + wc * 32 + 4 * fq;
        const bool latent = u.pm < (MLAT / 256);
        const int mr = latent ? (u.pm >> 4) : 8;
        f32x4 g4[2][2];
#pragma unroll
        for (int bj = 0; bj < 2; ++bj)
#pragma unroll
            for (int n = 0; n < 2; ++n) g4[bj][n] = *(const f32x4*)(gate + (size_t)mr * 3072 + col0 + bj * 128 + n * 16);
#pragma unroll
        for (int ai = 0; ai < 2; ++ai)
#pragma unroll
            for (int m = 0; m < 4; ++m) {
                const int row = row0 + ai * 128 + m * 16;
                const float* xr = (latent ? xlat + (size_t)row * DM : xctx + (size_t)(row - MLAT) * DM) + col0;
                float* vr = V + (size_t)row * DM + col0;
#pragma unroll
                for (int bj = 0; bj < 2; ++bj)
#pragma unroll
                    for (int n = 0; n < 2; ++n) {
                        const f32x4 x4 = *(const f32x4*)(xr + bj * 128 + n * 16);
                        *(f32x4*)(vr + bj * 128 + n * 16) = x4 * DN_ALPHA + g4[bj][n] * acc[ai][bj][m][n];
                    }
            }
    }
};

__device__ __forceinline__ unsigned f2bf_bits(float f) { unsigned u = __builtin_bit_cast(unsigned, f); return (u + 0x7fffu + ((u >> 16) & 1u)) >> 16; }
__device__ __forceinline__ unsigned pk2(float lo, float hi) { return f2bf_bits(lo) | (f2bf_bits(hi) << 16); }
__device__ __forceinline__ void transpose_item(const float* W, int K, int N, bf16_t* WT, LAS float* scr, int item, int lane) {
    const int nblk = N / 32, kb = item / nblk, nb = item % nblk, k0 = 64 * kb, n0 = 32 * nb;
#pragma unroll 8
    for (int i = 0; i < 32; ++i) { const int kk = 2 * i + (lane >> 5); scr[kk * 33 + (lane & 31)] = W[(size_t)(k0 + kk) * N + n0 + (lane & 31)]; }
    asm volatile("s_waitcnt lgkmcnt(0)" ::: "memory");
    const int c = lane & 7;
#pragma unroll
    for (int j = 0; j < 4; ++j) { const int n = (lane >> 3) + 8 * j; const LAS float* s = scr + (8 * c) * 33 + n;
        u32x4 o; o.x = pk2(s[0 * 33], s[1 * 33]); o.y = pk2(s[2 * 33], s[3 * 33]); o.z = pk2(s[4 * 33], s[5 * 33]); o.w = pk2(s[6 * 33], s[7 * 33]);
        *(u32x4*)(WT + (size_t)(n0 + n) * K + k0 + 8 * c) = o; }
    asm volatile("s_waitcnt lgkmcnt(0)" ::: "memory");
}

struct Args {
    const float* x; const float* c; const float* ctx; const float* c_ctx; const float* w_ada; const float* b_ada; const float* ln_g; const float* ln_b;
    const float* w_in_ab; const float* w_out_ab; const float* sink_ab; const float* conv_ab; const float* w_in_c; const float* w_out_c; const float* lb_c; const float* gnorm_c;
    float* out; unsigned char* ws;
};

__device__ __forceinline__ void prologue_a(const Args& a, LAS unsigned char* lds, int tid, int bid, int G) {
    const int lane = tid & 63, wid = tid >> 6;
    float* mod = (float*)(a.ws + WS_MOD);
    for (int item = bid; item < 192; item += G) {
        const int l = item / 48, cgp = item % 48, col = cgp * 64 + lane;
        LAS float* s = (LAS float*)lds;
        for (int i = tid; i < 9 * 1024; i += NTHR) { const int r = i >> 10, k = i & 1023; const float cv = r < 8 ? a.c[r * 1024 + k] : a.c_ctx[k]; s[i] = silu_f(cv); }
        __syncthreads();
        const float* W = a.w_ada + (size_t)l * 1024 * 3072 + col;
        float acc[9];
#pragma unroll
        for (int r = 0; r < 9; ++r) acc[r] = 0.f;
        const int kbeg = wid * 128;
#pragma unroll 2
        for (int k = kbeg; k < kbeg + 128; k += 4) {
            const float w0 = W[(size_t)k * 3072], w1 = W[(size_t)(k + 1) * 3072], w2 = W[(size_t)(k + 2) * 3072], w3 = W[(size_t)(k + 3) * 3072];
#pragma unroll
            for (int r = 0; r < 9; ++r) { const f32x4 sv = *(const LAS f32x4*)(s + r * 1024 + k); acc[r] += sv[0] * w0 + sv[1] * w1 + sv[2] * w2 + sv[3] * w3; }
        }
        LAS float* red = (LAS float*)(lds + 40960);
#pragma unroll
        for (int r = 0; r < 9; ++r) red[(wid * 9 + r) * 64 + lane] = acc[r];
        __syncthreads();
        for (int t = tid; t < 576; t += NTHR) {
            const int r = t >> 6, cc = t & 63; float sum = 0.f;
#pragma unroll
            for (int w = 0; w < 8; ++w) sum += red[(w * 9 + r) * 64 + cc];
            mod[((size_t)l * 9 + r) * 3072 + cgp * 64 + cc] = sum + a.b_ada[l * 3072 + cgp * 64 + cc];
        }
        __syncthreads();
    }
    if (bid == G - 1) {
        float* lbv = (float*)(a.ws + WS_LB);
        for (int i = tid; i < 2048; i += NTHR) { const int d = i >> 10, cch = i & 1023; const float l0 = a.lb_c[(d * 2 + 0) * 1024 + cch], l1 = a.lb_c[(d * 2 + 1) * 1024 + cch];
            lbv[(d * 2 + 0) * 1024 + cch] = 0.f; lbv[(d * 2 + 1) * 1024 + cch] = 1.f / (1.f + __expf(l0 - l1)); }
    }
    if (bid == G - 2 || G == 1) {
        float* rp = (float*)(a.ws + WS_ROPE);
        for (int i = tid; i < 1024; i += NTHR) { const int pos = i >> 4, fi = i & 15; const float fr = exp2f(-(float)fi * (13.287712379549449f / 16.f)); const float ang = (float)pos * fr;
            rp[2 * i] = __cosf(ang); rp[2 * i + 1] = __sinf(ang); }
    }
    LAS float* scr = (LAS float*)(lds + wid * 16384);
    const int gw = bid * NWAVES + wid, NGW = G * NWAVES;
    constexpr int I_AB = 16 * (NAB / 32), I_O = 16 * 32, I_C = 16 * (NCC / 32);
    constexpr int NITEMS = 2 * (I_AB + I_O + I_C + I_O);
    for (int it = gw; it < NITEMS; it += NGW) {
        int r = it;
        if (r < 2 * I_AB) { const int j = r / I_AB; transpose_item(a.w_in_ab + (size_t)j * DM * NAB, DM, NAB, (bf16_t*)(a.ws + WS_WINAB) + (size_t)j * NAB * DM, scr, r % I_AB, lane); continue; } r -= 2 * I_AB;
        if (r < 2 * I_O) { const int j = r / I_O; transpose_item(a.w_out_ab + (size_t)j * DM * DM, DM, DM, (bf16_t*)(a.ws + WS_WOUTAB) + (size_t)j * DM * DM, scr, r % I_O, lane); continue; } r -= 2 * I_O;
        if (r < 2 * I_C) { const int j = r / I_C; transpose_item(a.w_in_c + (size_t)j * DM * NCC, DM, NCC, (bf16_t*)(a.ws + WS_WINC) + (size_t)j * NCC * DM, scr, r % I_C, lane); continue; } r -= 2 * I_C;
        { const int j = r / I_O; transpose_item(a.w_out_c + (size_t)j * DM * DM, DM, DM, (bf16_t*)(a.ws + WS_WOUTC) + (size_t)j * DM * DM, scr, r % I_O, lane); }
    }
}
__device__ __forceinline__ void prologue_b(const Args& a, int tid, int bid, int G) {
    const int lane = tid & 63, wid = tid >> 6;
    const float* mod = (const float*)(a.ws + WS_MOD);
    bf16_t* H = (bf16_t*)(a.ws + WS_HU);
    for (int m = bid * NWAVES + wid; m < MTOT; m += G * NWAVES) {
        const float* src = m < MLAT ? a.x + (size_t)m * DM : a.ctx + (size_t)(m - MLAT) * DM;
        const float* md = mod + (size_t)(m < MLAT ? (m >> 12) : 8) * 3072;
#pragma unroll
        for (int j = 0; j < 4; ++j) {
            const int cix = 4 * lane + 256 * j;
            const f32x4 v = *(const f32x4*)(src + cix), sh = *(const f32x4*)(md + cix), sc = *(const f32x4*)(md + 1024 + cix);
            const f32x4 o = v * (sc + 1.f) + sh;
            u32x2 w; w.x = pkbf(o[0], o[1]); w.y = pkbf(o[2], o[3]);
            *(u32x2*)(H + (size_t)m * DM + cix) = w;
        }
    }
}
__device__ __forceinline__ void ln_phase(const Args& a, int l, int mrows, int tid, int bid, int G) {
    const int lane = tid & 63, wid = tid >> 6;
    const float* V = (const float*)(a.ws + WS_PROJ);
    const float* mod = (const float*)(a.ws + WS_MOD) + (size_t)(l + 1) * 9 * 3072;
    float* XC = (float*)(a.ws + WS_XC);
    bf16_t* H = (bf16_t*)(a.ws + WS_HU);
    const float* gam = a.ln_g + l * DM; const float* bet = a.ln_b + l * DM;
    for (int m = bid * NWAVES + wid; m < mrows; m += G * NWAVES) {
        const float* vr = V + (size_t)m * DM;
        f32x4 v[4]; float s = 0.f;
#pragma unroll
        for (int j = 0; j < 4; ++j) { v[j] = *(const f32x4*)(vr + 4 * lane + 256 * j); s += (v[j][0] + v[j][1]) + (v[j][2] + v[j][3]); }
        const float mean = wave_sum(s, lane) * (1.f / DM); float s2 = 0.f;
#pragma unroll
        for (int j = 0; j < 4; ++j) { v[j] = v[j] - mean; s2 += (v[j][0] * v[j][0] + v[j][1] * v[j][1]) + (v[j][2] * v[j][2] + v[j][3] * v[j][3]); }
        const float rstd = 1.f / sqrtf(wave_sum(s2, lane) * (1.f / DM) + LN_EPS);
        float* xo = m < MLAT ? a.out + (size_t)m * DM : XC + (size_t)(m - MLAT) * DM;
        const float* md = mod + (size_t)(m < MLAT ? (m >> 12) : 8) * 3072;
#pragma unroll
        for (int j = 0; j < 4; ++j) {
            const int cix = 4 * lane + 256 * j;
            const f32x4 o = v[j] * rstd * *(const f32x4*)(gam + cix) + *(const f32x4*)(bet + cix);
            *(f32x4*)(xo + cix) = o;
            if (l < DEPTH - 1) {
                const f32x4 sh = *(const f32x4*)(md + cix), sc = *(const f32x4*)(md + 1024 + cix);
                const f32x4 hh = o * (sc + 1.f) + sh;
                u32x2 w; w.x = pkbf(hh[0], hh[1]); w.y = pkbf(hh[2], hh[3]);
                *(u32x2*)(H + (size_t)m * DM + cix) = w;
            }
        }
    }
}

#define LDS_BARRIER() asm volatile("s_waitcnt lgkmcnt(0)\n\ts_barrier" ::: "memory")
__device__ __forceinline__ int crow(int r, int hi) { return (r & 3) + 8 * (r >> 2) + 4 * hi; }
constexpr int AT_KP = 72, AT_VP = 72, AT_OP = 68;
constexpr int AT_KS = 0, AT_VT = 2 * 64 * AT_KP * 2, AT_OS = AT_VT + 2 * 64 * AT_VP * 2;
__device__ __forceinline__ void attn_phase(LAS unsigned char* lds, const bf16_t* __restrict__ P, const float* __restrict__ sink, bf16_t* __restrict__ U, int tid, int bid, int G) {
    const int lane = tid & 63, wid = tid >> 6, q32 = lane & 31, hi = lane >> 5;
    LAS bf16_t* Ks = (LAS bf16_t*)(lds + AT_KS);
    LAS bf16_t* Vt = (LAS bf16_t*)(lds + AT_VT);
    LAS float* Os = (LAS float*)(lds + AT_OS) + wid * 32 * AT_OP;
    const int lkey = tid >> 3, lch = tid & 7;
    for (int u = bid; u < 1088; u += G) {
        bool isctx; int b, kh, qb;
        if (u < 64) { isctx = true; b = u >> 3; kh = (u >> 2) & 1; qb = u & 3; }
        else { const int v = u - 64; isctx = false; b = v >> 7; kh = (v >> 6) & 1; qb = v & 63; }
        const int h = kh * 4 + (wid & 3), rg = wid >> 2;
        const int qrow0 = (isctx ? MLAT + b * CTXL : b * SEQ) + qb * 64 + rg * 32;
        const int qpos = qb * 64 + rg * 32 + q32;
        bf16x8 qf[4];
#pragma unroll
        for (int kk = 0; kk < 4; ++kk) qf[kk] = *(const bf16x8*)(P + (size_t)(qrow0 + q32) * NAB + h * 64 + kk * 16 + hi * 8);
        int jlo = 0, nt = 4;
        if (!isctx) { jlo = qb < 2 ? 2 - qb : 0; const int jhi = (65 - qb) < 4 ? (65 - qb) : 4; nt = 4 + (jhi - jlo + 1); }
        float mrun = sink[h] * LOG2E, lrun = hi == 0 ? 1.f : 0.f;
        f32x16 o0, o1;
#pragma unroll
        for (int r = 0; r < 16; ++r) { o0[r] = 0.f; o1[r] = 0.f; }
        u32x4 kreg, vreg;
#define AT_LOAD(i) do { const int rb_ = (i) < 4 ? MLAT + b * CTXL + 64 * (i) : b * SEQ + 64 * (qb - 2 + jlo + (i) - 4); \
            const bf16_t* src_ = P + (size_t)(rb_ + lkey) * NAB + 512 + kh * 64 + lch * 8; kreg = *(const u32x4*)src_; vreg = *(const u32x4*)(src_ + 128); } while (0)
#define AT_STORE(buf) do { *(LAS u32x4*)(Ks + ((buf) * 64 + lkey) * AT_KP + lch * 8) = kreg; \
            LAS bf16_t* vd_ = Vt + ((buf) * 64 + lch * 8) * AT_VP + lkey; \
            vd_[0 * AT_VP] = (bf16_t)(vreg.x & 0xffffu); vd_[1 * AT_VP] = (bf16_t)(vreg.x >> 16); vd_[2 * AT_VP] = (bf16_t)(vreg.y & 0xffffu); vd_[3 * AT_VP] = (bf16_t)(vreg.y >> 16); \
            vd_[4 * AT_VP] = (bf16_t)(vreg.z & 0xffffu); vd_[5 * AT_VP] = (bf16_t)(vreg.z >> 16); vd_[6 * AT_VP] = (bf16_t)(vreg.w & 0xffffu); vd_[7 * AT_VP] = (bf16_t)(vreg.w >> 16); } while (0)
        AT_LOAD(0); AT_STORE(0);
        LDS_BARRIER();
        for (int i = 0; i < nt; ++i) {
            const int buf = i & 1;
            if (i + 1 < nt) AT_LOAD(i + 1);
            f32x16 s0, s1;
#pragma unroll
            for (int r = 0; r < 16; ++r) { s0[r] = 0.f; s1[r] = 0.f; }
#pragma unroll
            for (int kk = 0; kk < 4; ++kk) {
                const bf16x8 a0 = *(const LAS bf16x8*)(Ks + (buf * 64 + q32) * AT_KP + kk * 16 + hi * 8);
                const bf16x8 a1 = *(const LAS bf16x8*)(Ks + (buf * 64 + 32 + q32) * AT_KP + kk * 16 + hi * 8);
                s0 = __builtin_amdgcn_mfma_f32_32x32x16_bf16(a0, qf[kk], s0, 0, 0, 0);
                s1 = __builtin_amdgcn_mfma_f32_32x32x16_bf16(a1, qf[kk], s1, 0, 0, 0);
            }
            if (i >= 4) {
                const int kp0 = 64 * (qb - 2 + jlo + i - 4) - qpos;
#pragma unroll
                for (int r = 0; r < 16; ++r) { const int d0 = kp0 + crow(r, hi); if (d0 > 128 || d0 < -128) s0[r] = -__builtin_inff(); const int d1 = d0 + 32; if (d1 > 128 || d1 < -128) s1[r] = -__builtin_inff(); }
            }
            float mx = s0[0];
#pragma unroll
            for (int r = 1; r < 16; ++r) mx = fmaxf(mx, s0[r]);
#pragma unroll
            for (int r = 0; r < 16; ++r) mx = fmaxf(mx, s1[r]);
            mx = fmaxf(mx, shflx(mx, lane, 32));
            const float mnew = fmaxf(mrun, mx), alpha = __builtin_amdgcn_exp2f(mrun - mnew);
            mrun = mnew;
            float ls = 0.f;
#pragma unroll
            for (int r = 0; r < 16; ++r) { s0[r] = __builtin_amdgcn_exp2f(s0[r] - mnew); s1[r] = __builtin_amdgcn_exp2f(s1[r] - mnew); ls += s0[r] + s1[r]; }
            lrun = lrun * alpha + ls;
#pragma unroll
            for (int r = 0; r < 16; ++r) { o0[r] *= alpha; o1[r] *= alpha; }
#pragma unroll
            for (int sub = 0; sub < 2; ++sub)
#pragma unroll
                for (int st = 0; st < 2; ++st) {
                    u32x4 pw;
                    if (sub == 0) { pw.x = pkbf(s0[8 * st + 0], s0[8 * st + 1]); pw.y = pkbf(s0[8 * st + 2], s0[8 * st + 3]); pw.z = pkbf(s0[8 * st + 4], s0[8 * st + 5]); pw.w = pkbf(s0[8 * st + 6], s0[8 * st + 7]); }
                    else          { pw.x = pkbf(s1[8 * st + 0], s1[8 * st + 1]); pw.y = pkbf(s1[8 * st + 2], s1[8 * st + 3]); pw.z = pkbf(s1[8 * st + 4], s1[8 * st + 5]); pw.w = pkbf(s1[8 * st + 6], s1[8 * st + 7]); }
                    const bf16x8 pb = __builtin_bit_cast(bf16x8, pw);
                    const int kc = 32 * sub + 16 * st + 4 * hi;
                    {
                        const LAS bf16_t* vp = Vt + (buf * 64 + q32) * AT_VP + kc;
                        u32x4 aw; const u32x2 lo = *(const LAS u32x2*)vp, hh = *(const LAS u32x2*)(vp + 8); aw.x = lo.x; aw.y = lo.y; aw.z = hh.x; aw.w = hh.y;
                        o0 = __builtin_amdgcn_mfma_f32_32x32x16_bf16(__builtin_bit_cast(bf16x8, aw), pb, o0, 0, 0, 0);
                    }
                    {
                        const LAS bf16_t* vp = Vt + (buf * 64 + 32 + q32) * AT_VP + kc;
                        u32x4 aw; const u32x2 lo = *(const LAS u32x2*)vp, hh = *(const LAS u32x2*)(vp + 8); aw.x = lo.x; aw.y = lo.y; aw.z = hh.x; aw.w = hh.y;
                        o1 = __builtin_amdgcn_mfma_f32_32x32x16_bf16(__builtin_bit_cast(bf16x8, aw), pb, o1, 0, 0, 0);
                    }
                }
            if (i + 1 < nt) AT_STORE(buf ^ 1);
            LDS_BARRIER();
        }
#undef AT_LOAD
#undef AT_STORE
        const float linv = 1.f / (lrun + shflx(lrun, lane, 32));
#pragma unroll
        for (int r = 0; r < 16; ++r) { Os[q32 * AT_OP + crow(r, hi)] = o0[r] * linv; Os[q32 * AT_OP + 32 + crow(r, hi)] = o1[r] * linv; }
        asm volatile("s_waitcnt lgkmcnt(0)" ::: "memory");
#pragma unroll
        for (int it = 0; it < 4; ++it) {
            const int qq = it * 8 + (lane >> 3), ch = lane & 7;
            const f32x4 x0 = *(const LAS f32x4*)(Os + qq * AT_OP + ch * 8), x1 = *(const LAS f32x4*)(Os + qq * AT_OP + ch * 8 + 4);
            const size_t row = (size_t)(qrow0 + qq);
            const u32x4 gw = *(const u32x4*)(P + row * NAB + 768 + h * 64 + ch * 8);
            u32x4 w;
            w.x = pkbf(x0[0] * silu_f(bflo(gw.x)), x0[1] * silu_f(bfhi(gw.x))); w.y = pkbf(x0[2] * silu_f(bflo(gw.y)), x0[3] * silu_f(bfhi(gw.y)));
            w.z = pkbf(x1[0] * silu_f(bflo(gw.z)), x1[1] * silu_f(bfhi(gw.z))); w.w = pkbf(x1[2] * silu_f(bflo(gw.w)), x1[3] * silu_f(bfhi(gw.w)));
            *(u32x4*)(U + row * DM + h * 64 + ch * 8) = w;
        }
        asm volatile("s_waitcnt lgkmcnt(0)" ::: "memory");
    }
}
__device__ __forceinline__ void conv_phase(const bf16_t* __restrict__ P, const float* __restrict__ cw, bf16_t* __restrict__ U, int tid, int bid, int G) {
    const long total = (long)MTOT * 64;
    for (long idx = (long)bid * NTHR + tid; idx < total; idx += (long)G * NTHR) {
        const int ch = (int)(idx & 63); const int m = (int)(idx >> 6);
        int t, L; if (m < MLAT) { t = m & (SEQ - 1); L = SEQ; } else { t = (m - MLAT) & (CTXL - 1); L = CTXL; }
        const bf16_t* pr = P + (size_t)m * NAB + ch * 8;
        const u32x4 xb1 = *(const u32x4*)(pr + 1280), cg1 = *(const u32x4*)(pr + 2304), bg = *(const u32x4*)(pr + 1792), gb = *(const u32x4*)(pr + 2816);
        u32x4 xb0 = {0u, 0u, 0u, 0u}, cg0 = {0u, 0u, 0u, 0u}, xb2 = {0u, 0u, 0u, 0u}, cg2 = {0u, 0u, 0u, 0u};
        if (t > 0) { xb0 = *(const u32x4*)(pr - NAB + 1280); cg0 = *(const u32x4*)(pr - NAB + 2304); }
        if (t < L - 1) { xb2 = *(const u32x4*)(pr + NAB + 1280); cg2 = *(const u32x4*)(pr + NAB + 2304); }
        const float* w0 = cw + ch * 8; const float* w1 = cw + 512 + ch * 8; const float* w2 = cw + 1024 + ch * 8;
        const f32x4 w0a = *(const f32x4*)w0, w0b = *(const f32x4*)(w0 + 4), w1a = *(const f32x4*)w1, w1b = *(const f32x4*)(w1 + 4), w2a = *(const f32x4*)w2, w2b = *(const f32x4*)(w2 + 4);
        float o[8];
#define CV(j, XB0, CG0, XB1, CG1, XB2, CG2, BG, GB, W0, W1, W2, LOHI) { const float y = W0 * (LOHI(XB0) * LOHI(CG0)) + W1 * (LOHI(XB1) * LOHI(CG1)) + W2 * (LOHI(XB2) * LOHI(CG2)); o[j] = LOHI(BG) * y * silu_f(LOHI(GB)); }
        CV(0, xb0.x, cg0.x, xb1.x, cg1.x, xb2.x, cg2.x, bg.x, gb.x, w0a[0], w1a[0], w2a[0], bflo)
        CV(1, xb0.x, cg0.x, xb1.x, cg1.x, xb2.x, cg2.x, bg.x, gb.x, w0a[1], w1a[1], w2a[1], bfhi)
        CV(2, xb0.y, cg0.y, xb1.y, cg1.y, xb2.y, cg2.y, bg.y, gb.y, w0a[2], w1a[2], w2a[2], bflo)
        CV(3, xb0.y, cg0.y, xb1.y, cg1.y, xb2.y, cg2.y, bg.y, gb.y, w0a[3], w1a[3], w2a[3], bfhi)
        CV(4, xb0.z, cg0.z, xb1.z, cg1.z, xb2.z, cg2.z, bg.z, gb.z, w0b[0], w1b[0], w2b[0], bflo)
        CV(5, xb0.z, cg0.z, xb1.z, cg1.z, xb2.z, cg2.z, bg.z, gb.z, w0b[1], w1b[1], w2b[1], bfhi)
        CV(6, xb0.w, cg0.w, xb1.w, cg1.w, xb2.w, cg2.w, bg.w, gb.w, w0b[2], w1b[2], w2b[2], bflo)
        CV(7, xb0.w, cg0.w, xb1.w, cg1.w, xb2.w, cg2.w, bg.w, gb.w, w0b[3], w1b[3], w2b[3], bfhi)
#undef CV
        u32x4 w; w.x = pkbf(o[0], o[1]); w.y = pkbf(o[2], o[3]); w.z = pkbf(o[4], o[5]); w.w = pkbf(o[6], o[7]);
        *(u32x4*)(U + (size_t)m * DM + 512 + ch * 8) = w;
    }
}
typedef short v4i16_t __attribute__((ext_vector_type(4)));
__device__ __forceinline__ v4i16_t lds_tr(const LAS bf16_t* p) { return __builtin_amdgcn_ds_read_tr16_b64_v4i16((LAS v4i16_t*)p); }
template <int CTRL> __device__ __forceinline__ float dpp_f(float x) { return __int_as_float(__builtin_amdgcn_update_dpp(0x3f800000, __float_as_int(x), CTRL, 0xF, 0xF, false)); }
constexpr int SC_QP = 136, SC_TP = 40;
constexpr int SC_ARR = 32 * SC_QP * 2, SC_TARR = 128 * SC_TP * 2;
constexpr int SC_QA = 0, SC_KA = SC_TARR, SC_PM = 2 * SC_TARR, SC_BETA = SC_PM + 32 * SC_TP * 2, SC_GAMMA = SC_BETA + 512, SC_BUF = SC_GAMMA + 512;
constexpr int SC_V = 2 * SC_BUF, SC_RZ = SC_V + 2 * SC_ARR, SC_RQ = SC_RZ + SC_ARR, SC_OB = SC_RQ + SC_ARR, SC_END = SC_OB + SC_ARR;
static_assert(SC_END <= 131072, "scan LDS map");
struct ScanCtx { int dir, b, zcol, qcol, icol, cv, vp, vch, w, d16, quad, troff, troffT; };
__device__ __forceinline__ int sc_rowbase(const ScanCtx& c, int n) { return n < 8 ? MLAT + c.b * CTXL + (c.dir ? 224 - 32 * n : 32 * n) : c.b * SEQ + (c.dir ? 4064 - 32 * (n - 8) : 32 * (n - 8)); }
__device__ __forceinline__ void sc_load(const ScanCtx& c, const bf16_t* P, int n, u32x4& zr, u32x4& qr, u32x4& vr) {
    const bf16_t* rp = P + (size_t)(sc_rowbase(c, n) + c.vp) * NCC + c.vch * 8; zr = *(const u32x4*)(rp + c.zcol); qr = *(const u32x4*)(rp + c.qcol); vr = *(const u32x4*)(rp + c.icol);
}
__device__ __forceinline__ void sc_stage(const ScanCtx& c, LAS unsigned char* lds, int n, const u32x4& zr, const u32x4& qr, const u32x4& vr) {
    *(LAS u32x4*)((LAS bf16_t*)(lds + SC_RZ) + c.cv * SC_QP + c.vch * 8) = zr; *(LAS u32x4*)((LAS bf16_t*)(lds + SC_RQ) + c.cv * SC_QP + c.vch * 8) = qr;
    *(LAS u32x4*)((LAS bf16_t*)(lds + SC_V + (n & 1) * SC_ARR) + c.cv * SC_QP + c.vch * 8) = vr;
}
__device__ __forceinline__ void scan_step(const ScanCtx& c, LAS unsigned char* lds, bf16_t* P, int n, f32x4 (&S)[8], u32x4& zr, u32x4& qr, u32x4& vr) {
    const int w = c.w, d16 = c.d16, quad = c.quad;
    LAS bf16_t* RZ = (LAS bf16_t*)(lds + SC_RZ); LAS bf16_t* RQ = (LAS bf16_t*)(lds + SC_RQ); LAS bf16_t* OB = (LAS bf16_t*)(lds + SC_OB);
    LAS unsigned char* B = lds + (n & 1) * SC_BUF;
    LAS bf16_t* QA = (LAS bf16_t*)(B + SC_QA); LAS bf16_t* KA = (LAS bf16_t*)(B + SC_KA); LAS bf16_t* PM = (LAS bf16_t*)(B + SC_PM);
    LAS float* BETA = (LAS float*)(B + SC_BETA); LAS float* GAMMA = (LAS float*)(B + SC_GAMMA);
    const LAS bf16_t* VV = (const LAS bf16_t*)(lds + SC_V + (n & 1) * SC_ARR);
    {
        const LAS bf16_t* zp_ = RZ + (8 * quad) * SC_QP + 16 * w + c.troff; const LAS bf16_t* qp_ = RQ + (8 * quad) * SC_QP + 16 * w + c.troff;
        const v4i16_t z0 = lds_tr(zp_), z1 = lds_tr(zp_ + 4 * SC_QP), q0 = lds_tr(qp_), q1 = lds_tr(qp_ + 4 * SC_QP);
        float kk[8], qv[8], lp[8], ls[8];
#pragma unroll
        for (int i = 0; i < 4; ++i) { kk[i] = h2f((unsigned short)z0[i]); kk[4 + i] = h2f((unsigned short)z1[i]); qv[i] = bf2f((unsigned short)q0[i]); qv[4 + i] = bf2f((unsigned short)q1[i]); }
        float run = 1.f;
#pragma unroll
        for (int i = 0; i < 8; ++i) { run *= (1.f - kk[i]); lp[i] = run; }
        float rs = 1.f;
#pragma unroll
        for (int i = 7; i >= 0; --i) { ls[i] = rs; rs *= (1.f - kk[i]); }
        const int runi = __float_as_int(run);
        const float t0 = __int_as_float(__builtin_amdgcn_ds_bpermute(d16 << 2, runi)), t1 = __int_as_float(__builtin_amdgcn_ds_bpermute((d16 + 16) << 2, runi)),
                    t2 = __int_as_float(__builtin_amdgcn_ds_bpermute((d16 + 32) << 2, runi)), t3 = __int_as_float(__builtin_amdgcn_ds_bpermute((d16 + 48) << 2, runi));
        const float gmul = quad == 3 ? t2 : quad == 0 ? t1 : 1.f;
        const bool up = quad >= 2;
        float qa[8], ka[8];
#pragma unroll
        for (int i = 0; i < 8; ++i) {
            const float g = (up ? lp[i] : ls[i]) * gmul, ig = __builtin_amdgcn_rcpf(g);
            qa[i] = qv[i] * (up ? g : ig); ka[i] = kk[i] * (up ? ig : g);
        }
        const int d = 16 * w + d16;
        *(LAS u32x4*)(QA + d * SC_TP + 8 * quad) = (u32x4){pkbf(qa[0], qa[1]), pkbf(qa[2], qa[3]), pkbf(qa[4], qa[5]), pkbf(qa[6], qa[7])};
        *(LAS u32x4*)(KA + d * SC_TP + 8 * quad) = (u32x4){pkbf(ka[0], ka[1]), pkbf(ka[2], ka[3]), pkbf(ka[4], ka[5]), pkbf(ka[6], ka[7])};
        if (quad == 0) { BETA[d] = t0 * t1; GAMMA[d] = t2 * t3; }
    }
    LDS_BARRIER();
        if (n + 1 < 136) { sc_stage(c, lds, n + 1, zr, qr, vr); if (n + 5 < 136) sc_load(c, P, n + 5, zr, qr, vr); }
    if (n > 0) { const u32x4 ov = *(const LAS u32x4*)(OB + c.cv * SC_QP + c.vch * 8); *(u32x4*)(P + (size_t)(sc_rowbase(c, n - 1) + c.vp) * NCC + c.zcol + c.vch * 8) = ov; }
    if (w < 4) {
        const int ct = w >> 1, st = w & 1;
        f32x4 sc = {0.f, 0.f, 0.f, 0.f};
        if (st <= ct) {
#pragma unroll
            for (int k4 = 0; k4 < 4; ++k4) {
                const LAS bf16_t* ap_ = QA + (32 * k4 + 8 * quad) * SC_TP + 16 * ct + c.troffT; const LAS bf16_t* bp_ = KA + (32 * k4 + 8 * quad) * SC_TP + 16 * st + c.troffT;
                const v4i16_t a0 = lds_tr(ap_), a1 = lds_tr(ap_ + 4 * SC_TP), b0 = lds_tr(bp_), b1 = lds_tr(bp_ + 4 * SC_TP);
                const bf16x8 av = (bf16x8){a0[0], a0[1], a0[2], a0[3], a1[0], a1[1], a1[2], a1[3]}, bv = (bf16x8){b0[0], b0[1], b0[2], b0[3], b1[0], b1[1], b1[2], b1[3]};
                sc = __builtin_amdgcn_mfma_f32_16x16x32_bf16(av, bv, sc, 0, 0, 0);
            }
        }
#pragma unroll
        for (int r = 0; r < 4; ++r) { const int cc = 16 * ct + 4 * quad + r, ss = 16 * st + d16; PM[cc * SC_TP + ss] = f2bf1(ss <= cc ? sc[r] : 0.f); }
    }
    f32x4 O0 = {0.f, 0.f, 0.f, 0.f}, O1 = {0.f, 0.f, 0.f, 0.f};
#pragma unroll
    for (int k4 = 0; k4 < 4; ++k4) {
        const f32x4 b0 = *(const LAS f32x4*)(BETA + 32 * k4 + 4 * quad), b1 = *(const LAS f32x4*)(BETA + 32 * k4 + 16 + 4 * quad);
        const f32x4 s0 = S[2 * k4] * b0, s1 = S[2 * k4 + 1] * b1;
        u32x4 bw; bw.x = pkbf(s0[0], s0[1]); bw.y = pkbf(s0[2], s0[3]); bw.z = pkbf(s1[0], s1[1]); bw.w = pkbf(s1[2], s1[3]);
        const bf16x8 bv = __builtin_bit_cast(bf16x8, bw);
        {
            const LAS bf16_t* ap = QA + (32 * k4 + 4 * quad) * SC_TP + c.troffT; const v4i16_t lo = lds_tr(ap), hh = lds_tr(ap + 16 * SC_TP);
            O0 = __builtin_amdgcn_mfma_f32_16x16x32_bf16((bf16x8){lo[0], lo[1], lo[2], lo[3], hh[0], hh[1], hh[2], hh[3]}, bv, O0, 0, 0, 0);
        }
        {
            const LAS bf16_t* ap = QA + (32 * k4 + 4 * quad) * SC_TP + 16 + c.troffT; const v4i16_t lo = lds_tr(ap), hh = lds_tr(ap + 16 * SC_TP);
            O1 = __builtin_amdgcn_mfma_f32_16x16x32_bf16((bf16x8){lo[0], lo[1], lo[2], lo[3], hh[0], hh[1], hh[2], hh[3]}, bv, O1, 0, 0, 0);
        }
    }
    LDS_BARRIER();
    bf16x8 vB;
    { const LAS bf16_t* vp_ = VV + (8 * quad) * SC_QP + 16 * w + c.troff; const v4i16_t lo = lds_tr(vp_), hh = lds_tr(vp_ + 4 * SC_QP);
      vB = (bf16x8){lo[0], lo[1], lo[2], lo[3], hh[0], hh[1], hh[2], hh[3]}; }
    O0 = __builtin_amdgcn_mfma_f32_16x16x32_bf16(*(const LAS bf16x8*)(PM + d16 * SC_TP + 8 * quad), vB, O0, 0, 0, 0);
    O1 = __builtin_amdgcn_mfma_f32_16x16x32_bf16(*(const LAS bf16x8*)(PM + (16 + d16) * SC_TP + 8 * quad), vB, O1, 0, 0, 0);
#pragma unroll
    for (int r = 0; r < 4; ++r) { OB[(4 * quad + r) * SC_QP + 16 * w + d16] = f2bf1(O0[r]); OB[(16 + 4 * quad + r) * SC_QP + 16 * w + d16] = f2bf1(O1[r]); }
#pragma unroll
    for (int dt = 0; dt < 8; ++dt) {
        const f32x4 be = *(const LAS f32x4*)(BETA + 16 * dt + 4 * quad), ga = *(const LAS f32x4*)(GAMMA + 16 * dt + 4 * quad);
        const bf16x8 kA = *(const LAS bf16x8*)(KA + (16 * dt + d16) * SC_TP + 8 * quad);
        const f32x4 T = __builtin_amdgcn_mfma_f32_16x16x32_bf16(kA, vB, (f32x4){0.f, 0.f, 0.f, 0.f}, 0, 0, 0);
        S[dt] = S[dt] * (be * ga) + T * ga;
    }
}
__device__ __forceinline__ void scan_phase(LAS unsigned char* lds, bf16_t* P, int tid, int bid, int G) {
    ScanCtx c;
    const int lane = tid & 63;
    c.w = tid >> 6; c.d16 = lane & 15; c.quad = lane >> 4; c.vp = tid >> 4; c.vch = tid & 15;
    c.troffT = ((c.d16 >> 2) * SC_TP + (c.d16 & 3) * 4);
    c.troff = ((c.d16 >> 2) * SC_QP + (c.d16 & 3) * 4);
    for (int item = bid; item < 128; item += G) {
        const int bh = item >> 1, h = bh & 7;
        c.dir = item & 1; c.b = bh >> 3;
        c.zcol = (c.dir ? 2048 : 1024) + h * 128; c.qcol = h * 128; c.icol = 3072 + h * 128;
        c.cv = c.dir ? 31 - c.vp : c.vp;
        f32x4 S[8];
#pragma unroll
        for (int i = 0; i < 8; ++i) S[i] = (f32x4){0.f, 0.f, 0.f, 0.f};
        u32x4 z0, q0, v0, z1, q1, v1, z2, q2, v2, z3, q3, v3;
        sc_load(c, P, 0, z0, q0, v0); sc_stage(c, lds, 0, z0, q0, v0);
        sc_load(c, P, 1, z1, q1, v1); sc_load(c, P, 2, z2, q2, v2); sc_load(c, P, 3, z3, q3, v3); sc_load(c, P, 4, z0, q0, v0);
        LDS_BARRIER();
        for (int n = 0; n < 136; n += 4) {
            scan_step(c, lds, P, n, S, z1, q1, v1);
            scan_step(c, lds, P, n + 1, S, z2, q2, v2);
            scan_step(c, lds, P, n + 2, S, z3, q3, v3);
            scan_step(c, lds, P, n + 3, S, z0, q0, v0);
        }
        LDS_BARRIER();
        { const u32x4 ov = *(const LAS u32x4*)((LAS bf16_t*)(lds + SC_OB) + c.cv * SC_QP + c.vch * 8); *(u32x4*)(P + (size_t)(sc_rowbase(c, 135) + c.vp) * NCC + c.zcol + c.vch * 8) = ov; }
        LDS_BARRIER();
    }
}
__device__ __forceinline__ void readout_phase(const bf16_t* __restrict__ P, const float* __restrict__ gn, bf16_t* __restrict__ U, int mrows, int tid, int bid, int G) {
    const long total = (long)mrows * 128;
    for (long idx = (long)bid * NTHR + tid; idx < total; idx += (long)G * NTHR) {
        const int ch = (int)(idx & 15), h = (int)((idx >> 4) & 7); const int m = (int)(idx >> 7);
        const bf16_t* pr = P + (size_t)m * NCC + h * 128 + ch * 8;
        const u32x4 of = *(const u32x4*)(pr + 1024), ob = *(const u32x4*)(pr + 2048), gg = *(const u32x4*)(pr + 4096);
        float o[8];
        o[0] = bflo(of.x) + bflo(ob.x); o[1] = bfhi(of.x) + bfhi(ob.x); o[2] = bflo(of.y) + bflo(ob.y); o[3] = bfhi(of.y) + bfhi(ob.y);
        o[4] = bflo(of.z) + bflo(ob.z); o[5] = bfhi(of.z) + bfhi(ob.z); o[6] = bflo(of.w) + bflo(ob.w); o[7] = bfhi(of.w) + bfhi(ob.w);
        float ss = 0.f;
#pragma unroll
        for (int j = 0; j < 8; ++j) ss += o[j] * o[j];
        { const int ln_ = tid & 63; ss += shflx(ss, ln_, 1); ss += shflx(ss, ln_, 2); ss += shflx(ss, ln_, 4); ss += shflx(ss, ln_, 8); }
        const float rs = 1.f / sqrtf(ss * (1.f / 128.f) + RMS_EPS);
        const f32x4 g0 = *(const f32x4*)(gn + ch * 8), g1 = *(const f32x4*)(gn + ch * 8 + 4);
        u32x4 wv;
        wv.x = pkbf(o[0] * rs * g0[0] * silu_f(bflo(gg.x)), o[1] * rs * g0[1] * silu_f(bfhi(gg.x)));
        wv.y = pkbf(o[2] * rs * g0[2] * silu_f(bflo(gg.y)), o[3] * rs * g0[3] * silu_f(bfhi(gg.y)));
        wv.z = pkbf(o[4] * rs * g1[0] * silu_f(bflo(gg.z)), o[5] * rs * g1[1] * silu_f(bfhi(gg.z)));
        wv.w = pkbf(o[6] * rs * g1[2] * silu_f(bflo(gg.w)), o[7] * rs * g1[3] * silu_f(bfhi(gg.w)));
        *(u32x4*)(U + (size_t)m * DM + h * 128 + ch * 8) = wv;
    }
}

__global__ void __launch_bounds__(NTHR, 2) fwd_megakernel(Args a) {
    extern __shared__ __attribute__((aligned(16))) unsigned char lds_raw[];
    LAS unsigned char* lds = (LAS unsigned char*)lds_raw;
    cg::grid_group grid = cg::this_grid();
    const int wave_s = __builtin_amdgcn_readfirstlane((int)threadIdx.x >> 6); const int bid = blockIdx.x, G = gridDim.x;
#define XSYNC() do {} while (0)
#define GSYNC() xcd_barrier(xbar, wave_s)
#define FRESH_TID() const int tid = wave_s * 64 + pg8::fresh_lane()
    if (threadIdx.x < 4) ((volatile LAS unsigned*)(lds + 131072 + 256))[threadIdx.x] = 0u;
    __syncthreads();
    const XcdBarrier xbar = xcd_barrier_post((unsigned*)a.ws, (volatile LAS unsigned*)(lds + 131072 + 256));
    bf16_t* HU = (bf16_t*)(a.ws + WS_HU);
    bf16_t* PROJ = (bf16_t*)(a.ws + WS_PROJ);
    float* VPRE = (float*)(a.ws + WS_PROJ);
    const float* mod = (const float*)(a.ws + WS_MOD);
    { FRESH_TID(); prologue_a(a, lds, tid, bid, G); }
    grid.sync(); XSYNC();
    { FRESH_TID(); prologue_b(a, tid, bid, G); }
    GSYNC(); XSYNC();
#pragma nounroll
    for (int l = 0; l < DEPTH; ++l) {
        const int j = l >> 1;
        const int mrows = (l == DEPTH - 1) ? MLAT : MTOT;
        if ((l & 1) == 0) {
            { pg8::Gemm g{HU, (const bf16_t*)(a.ws + WS_WINAB) + (size_t)j * NAB * DM, MTOT, NAB, DM, wave_s}; pg8::StaticOrder S; S.init(MTOT, NAB, G, bid);
              EpiAB E{PROJ, (const float*)(a.ws + WS_ROPE)};
              pg8::gemm_phase<EpiAB, pg8::StaticOrder, PG8_ALIGN, PG8_SP2>(lds, g, S, E); }
            GSYNC(); XSYNC();
            { FRESH_TID(); attn_phase(lds, PROJ, a.sink_ab + j * 8, HU, tid, bid, G); }
#ifdef PROBE_ATTN2
            { FRESH_TID(); attn_phase(lds, PROJ, a.sink_ab + j * 8, HU, tid, bid, G); }
#endif
            { FRESH_TID(); conv_phase(PROJ, a.conv_ab + j * 3 * 512, HU, tid, bid, G); }
            GSYNC(); XSYNC();
        } else {
            { pg8::Gemm g{HU, (const bf16_t*)(a.ws + WS_WINC) + (size_t)j * NCC * DM, MTOT, NCC, DM, wave_s}; pg8::StaticOrder S; S.init(MTOT, NCC, G, bid);
              EpiC E{PROJ, (const float*)(a.ws + WS_LB) + j * 1024};
              pg8::gemm_phase<EpiC, pg8::StaticOrder, PG8_ALIGN, PG8_SP2>(lds, g, S, E); }
            GSYNC(); XSYNC();
            { FRESH_TID(); scan_phase(lds, PROJ, tid, bid, G); }
            GSYNC(); XSYNC();
            { FRESH_TID(); readout_phase(PROJ, a.gnorm_c + j * 128, HU, mrows, tid, bid, G); }
            GSYNC(); XSYNC();
        }
        { const bf16_t* wo = (l & 1) ? (const bf16_t*)(a.ws + WS_WOUTC) + (size_t)j * DM * DM : (const bf16_t*)(a.ws + WS_WOUTAB) + (size_t)j * DM * DM;
          pg8::Gemm g{HU, wo, mrows, DM, DM, wave_s}; pg8::StaticOrder S; S.init(mrows, DM, G, bid);
          EpiOut E{l == 0 ? a.x : a.out, l == 0 ? a.ctx : (const float*)(a.ws + WS_XC), mod + (size_t)l * 9 * 3072 + 2048, VPRE};
          pg8::gemm_phase<EpiOut, pg8::StaticOrder, PG8_ALIGN, PG8_SP2>(lds, g, S, E); }
        GSYNC(); XSYNC();
        { FRESH_TID(); ln_phase(a, l, mrows, tid, bid, G); }
        if (l < DEPTH - 1) { GSYNC(); XSYNC(); }
    }
}

extern "C" void kernel_launch(void* const* d_in, const int* in_sizes, int n_in, void* d_out, int out_size, void* d_ws, size_t ws_size, hipStream_t stream) {
    static int grid_blocks = 0;
    if (grid_blocks == 0) {
        if (n_in != 16 || ws_size < WS_END) { fprintf(stderr, "kernel_launch: unexpected n_in %d / ws_size %zu\n", n_in, ws_size); grid_blocks = -1; return; }
        int dev = 0, cus = 0, per_cu = 0;
        hipGetDevice(&dev);
        hipDeviceGetAttribute(&cus, hipDeviceAttributeMultiprocessorCount, dev);
        if (hipFuncSetAttribute((const void*)fwd_megakernel, hipFuncAttributeMaxDynamicSharedMemorySize, LDS_BYTES) != hipSuccess) { fprintf(stderr, "kernel_launch: hipFuncSetAttribute failed\n"); grid_blocks = -1; return; }
        if (hipOccupancyMaxActiveBlocksPerMultiprocessor(&per_cu, (const void*)fwd_megakernel, NTHR, LDS_BYTES) != hipSuccess || per_cu < 1) { fprintf(stderr, "kernel_launch: occupancy query gave %d\n", per_cu); per_cu = 1; }
        (void)hipGetLastError();
        grid_blocks = cus * per_cu;
        fprintf(stderr, "kernel_launch: cus %d per_cu %d grid %d ws %zu\n", cus, per_cu, grid_blocks, ws_size);
    }
    if (grid_blocks < 0) return;
    Args a{};
    a.x = (const float*)d_in[0]; a.c = (const float*)d_in[1]; a.ctx = (const float*)d_in[2]; a.c_ctx = (const float*)d_in[3]; a.w_ada = (const float*)d_in[4]; a.b_ada = (const float*)d_in[5];
    a.ln_g = (const float*)d_in[6]; a.ln_b = (const float*)d_in[7]; a.w_in_ab = (const float*)d_in[8]; a.w_out_ab = (const float*)d_in[9]; a.sink_ab = (const float*)d_in[10]; a.conv_ab = (const float*)d_in[11];
    a.w_in_c = (const float*)d_in[12]; a.w_out_c = (const float*)d_in[13]; a.lb_c = (const float*)d_in[14]; a.gnorm_c = (const float*)d_in[15];
    a.out = (float*)d_out; a.ws = (unsigned char*)d_ws;
    if (hipMemsetAsync(d_ws, 0, 16384, stream) != hipSuccess) { fprintf(stderr, "kernel_launch: memset failed\n"); return; }
    void* args[] = {&a};
    hipError_t e = hipLaunchCooperativeKernel((const void*)fwd_megakernel, dim3(grid_blocks), dim3(NTHR), args, LDS_BYTES, stream);
    if (e != hipSuccess) fprintf(stderr, "kernel_launch: cooperative launch failed: %s (grid %d)\n", hipGetErrorString(e), grid_blocks);
}
```
